# Optimizing an MI355X kernel written in HIP

```python
import jax
import jax.numpy as jnp
from jax import lax
import numpy as np

D_MODEL = 1024
BATCH = 8
SEQ = 2048
DEPTH = 2

GRID_W = 64
CTX_LEN = 256
HG_DK = 128
HG_WIDTH = D_MODEL // 2
HG_HEADS = HG_WIDTH // HG_DK
HG_CHUNK = 64
SC_WIDTH = D_MODEL // 4
SC_TAPS = 3
SG_WIDTH = D_MODEL // 4
SG_HEADS = 4
SG_HEAD_DIM = SG_WIDTH // SG_HEADS
SG_CHUNK = 128
MIX_WIDTH = HG_WIDTH + SC_WIDTH + SG_WIDTH
HG_STATE_COLS = 3 * HG_WIDTH
IN_COLS = 5 * HG_WIDTH + 3 * SC_WIDTH + 2 * SG_WIDTH
D_FF = 2816
N_MOD = 6
ALPHA = (2 * DEPTH) ** 0.25
BETA = (8 * DEPTH) ** -0.25
EPS = 1e-6
TINY = 1e-30

O_Q = 3 * HG_WIDTH
O_G = 4 * HG_WIDTH
O_SC = 5 * HG_WIDTH
O_SG = O_SC + 3 * SC_WIDTH

kernel_name = 'hybrid_hgrn2_shortconv_chunkmlp_dit'

F32 = jnp.float32


def layer_norm(x, g=None, b=None):
    xf = x.astype(F32)
    xc = xf - jnp.mean(xf, axis=-1, keepdims=True)
    y = xc * lax.rsqrt(jnp.mean(xc * xc, axis=-1, keepdims=True) + EPS)
    if g is not None:
        y = y * g.astype(F32) + b.astype(F32)
    return y.astype(x.dtype)


def modulate(x, shift, scale):
    return layer_norm(x) * (1.0 + scale) + shift


def hg_lower_bounds(lb_logits):
    p = jax.nn.softmax(lb_logits.astype(F32), axis=0)
    return jnp.cumsum(p, axis=0) - p[:1]


def hg_forget(z, lb):
    z = z.astype(F32)
    k = (1.0 - lb) * jax.nn.sigmoid(-z)
    logf = jnp.log(jnp.maximum(lb + (1.0 - lb) * jax.nn.sigmoid(z), TINY))
    return k, logf


def split_heads(a):
    return a.reshape(a.shape[0], a.shape[1], HG_HEADS, HG_DK)


def flip(a):
    return a[:, ::-1]


def hg_state_inputs(p_state, lb_f, lb_b):
    i, z_f, z_b = jnp.split(p_state.astype(F32), 3, axis=-1)
    k_f, lf_f = hg_forget(z_f, lb_f)
    k_b, lf_b = hg_forget(z_b, lb_b)
    return (split_heads(i), split_heads(k_f), split_heads(k_b), split_heads(lf_f), split_heads(lf_b))


def gla_chunk_scan(q, k, v, logf, s0):
    bsz, t, h, dk = q.shape
    dv = v.shape[-1]
    n = t // HG_CHUNK

    def to_chunks(a):
        return a.astype(F32).reshape(bsz, n, HG_CHUNK, h, a.shape[-1]).transpose(1, 0, 3, 2, 4)

    causal = jnp.tril(jnp.ones((HG_CHUNK, HG_CHUNK), bool))[:, :, None]

    def step(s, inp):
        qc, kc, vc, gc = inp
        b = jnp.cumsum(gc, axis=2)
        inter = jnp.einsum('bhtk,bhkv->bhtv', qc * jnp.exp(b), s)
        diff = b[:, :, :, None, :] - b[:, :, None, :, :]
        decay = jnp.where(causal, jnp.exp(jnp.minimum(diff, 0.0)), 0.0)
        scores = jnp.einsum('bhtk,bhtsk,bhsk->bhts', qc, decay, kc)
        intra = jnp.einsum('bhts,bhsv->bhtv', scores, vc)
        b_last = b[:, :, -1:, :]
        s_new = jnp.exp(b_last[:, :, 0, :, None]) * s + jnp.einsum('bhsk,bhsv->bhkv', kc * jnp.exp(jnp.minimum(b_last - b, 0.0)), vc)
        return s_new, inter + intra

    _, o = lax.scan(step, s0.astype(F32), (to_chunks(q), to_chunks(k), to_chunks(v), to_chunks(logf)))
    return o.transpose(1, 0, 3, 2, 4).reshape(bsz, t, h, dv)


def gla_final_state(k, v, logf):
    suffix = jnp.minimum(lax.cumsum(logf, axis=1, reverse=True) - logf, 0.0)
    return jnp.einsum('bthk,bthv->bhkv', k * jnp.exp(suffix), v)


def hgrn2_bidir(q, v, k_f, k_b, lf_f, lf_b, s0_f, s0_b):
    o_f = gla_chunk_scan(q, k_f, v, lf_f, s0_f)
    o_b = flip(gla_chunk_scan(flip(q), flip(k_b), flip(v), flip(lf_b), s0_b))
    return o_f + o_b


def conv1d_centred(x, w):
    xp = jnp.pad(x, ((0, 0), (1, 1), (0, 0)))
    return xp[:, :-2] * w[0] + xp[:, 1:-1] * w[1] + xp[:, 2:] * w[2]


def chunk_spatial_gate(u, v, ln_g, ln_b, w_s, b_s):
    bsz, t, _ = v.shape
    n = t // SG_CHUNK
    vh = layer_norm(v.reshape(bsz, t, SG_HEADS, SG_HEAD_DIM),
                    ln_g.reshape(SG_HEADS, SG_HEAD_DIM), ln_b.reshape(SG_HEADS, SG_HEAD_DIM))
    vh = vh.reshape(bsz, n, SG_CHUNK, SG_HEADS, SG_HEAD_DIM)
    mixed = jnp.einsum('gts,bnsgc->bntgc', w_s, vh) + b_s.T[:, :, None]
    return u * mixed.reshape(bsz, t, SG_WIDTH)


def token_mixers(p, hg_in, s0_f, s0_b, hg_norm_g, sc_w, sg_ln_g, sg_ln_b, sg_w, sg_b):
    v, k_f, k_b, lf_f, lf_b = hg_in
    q = jax.nn.silu(split_heads(p[..., O_Q:O_G].astype(F32))) * HG_DK ** -0.5
    o = hgrn2_bidir(q, v, k_f, k_b, lf_f, lf_b, s0_f, s0_b)
    o = o * lax.rsqrt(jnp.mean(o * o, axis=-1, keepdims=True) + EPS) * hg_norm_g.astype(F32)
    hg = (o.reshape(o.shape[0], o.shape[1], HG_WIDTH) * jax.nn.silu(p[..., O_G:O_SC].astype(F32))).astype(p.dtype)
    gate_b, gate_c, h_sc = jnp.split(p[..., O_SC:O_SG], 3, axis=-1)
    sc = gate_b * conv1d_centred(gate_c * h_sc, sc_w)
    u, v_sg = jnp.split(p[..., O_SG:], 2, axis=-1)
    sg = chunk_spatial_gate(u, v_sg, sg_ln_g, sg_ln_b, sg_w, sg_b)
    return jnp.concatenate([hg, sc, sg], axis=-1)


def dwconv3x3(img, w):
    rows, cols = img.shape[1], img.shape[2]
    pad = jnp.pad(img, ((0, 0), (1, 1), (1, 1), (0, 0)))
    out = pad[:, 0:rows, 0:cols] * w[0, 0]
    for di in range(3):
        for dj in range(3):
            if di or dj:
                out = out + pad[:, di:di + rows, dj:dj + cols] * w[di, dj]
    return out


def conv_ffn(h, w_up, conv_w, conv_b, w_down, grid_rows):
    a, g = jnp.split(h @ w_up, 2, axis=-1)
    bsz, t, f = a.shape
    a = dwconv3x3(a.reshape(bsz, grid_rows, t // grid_rows, f), conv_w).reshape(bsz, t, f) + conv_b
    return (jax.nn.gelu(a, approximate=False) * g) @ w_down


def _normal(k, shape, scale):
    return jax.random.normal(k, shape, F32) * scale


def setup_inputs(seed: int = 0) -> dict:
    key = jax.random.key(seed)
    ks = jax.random.split(key, 23)
    return {
        'x': _normal(ks[0], (BATCH, SEQ, D_MODEL), 1.0),
        'c': _normal(ks[1], (BATCH, D_MODEL), 1.0),
        'ctx': _normal(ks[2], (BATCH, CTX_LEN, D_MODEL), 1.0),
        'c_ctx': _normal(ks[3], (D_MODEL,), 1.0),
        'ada_w': _normal(ks[4], (DEPTH, D_MODEL, N_MOD * D_MODEL), 0.5 * D_MODEL ** -0.5),
        'ada_b': _normal(ks[5], (DEPTH, N_MOD * D_MODEL), 0.02),
        'w_in': _normal(ks[6], (DEPTH, D_MODEL, IN_COLS), D_MODEL ** -0.5),
        'hg_lb': _normal(ks[7], (DEPTH, 2, HG_WIDTH), 1.0),
        'hg_norm_g': 1.0 + _normal(ks[8], (DEPTH, HG_DK), 0.02),
        'sc_conv_w': _normal(ks[9], (DEPTH, SC_TAPS, SC_WIDTH), SC_TAPS ** -0.5),
        'sg_ln_g': 1.0 + _normal(ks[10], (DEPTH, SG_WIDTH), 0.02),
        'sg_ln_b': _normal(ks[11], (DEPTH, SG_WIDTH), 0.02),
        'sg_w': _normal(ks[12], (DEPTH, SG_HEADS, SG_CHUNK, SG_CHUNK), 0.5 * SG_CHUNK ** -0.5),
        'sg_b': 1.0 + _normal(ks[13], (DEPTH, SG_HEADS, SG_CHUNK), 0.02),
        'w_out': _normal(ks[14], (DEPTH, MIX_WIDTH, D_MODEL), BETA * MIX_WIDTH ** -0.5),
        'ln1_g': 1.0 + _normal(ks[15], (DEPTH, D_MODEL), 0.02),
        'ln1_b': _normal(ks[16], (DEPTH, D_MODEL), 0.02),
        'ffn_up': _normal(ks[17], (DEPTH, D_MODEL, 2 * D_FF), D_MODEL ** -0.5),
        'ffn_conv_w': _normal(ks[18], (DEPTH, 3, 3, D_FF), 1.0 / 3.0),
        'ffn_conv_b': _normal(ks[19], (DEPTH, D_FF), 0.02),
        'ffn_down': _normal(ks[20], (DEPTH, D_FF, D_MODEL), BETA * D_FF ** -0.5),
        'ln2_g': 1.0 + _normal(ks[21], (DEPTH, D_MODEL), 0.02),
        'ln2_b': _normal(ks[22], (DEPTH, D_MODEL), 0.02),
    }


def reference(x, c, ctx, c_ctx, ada_w, ada_b, w_in, hg_lb, hg_norm_g, sc_conv_w, sg_ln_g, sg_ln_b,
              sg_w, sg_b, w_out, ln1_g, ln1_b, ffn_up, ffn_conv_w, ffn_conv_b, ffn_down, ln2_g, ln2_b):
    rows = x.shape[1] // GRID_W
    lower = hg_lower_bounds(hg_lb)
    silu_c = jax.nn.silu(c)
    silu_cc = jax.nn.silu(c_ctx)
    for l in range(DEPTH):
        last = l == DEPTH - 1
        mx = jnp.split((silu_c @ ada_w[l] + ada_b[l])[:, None, :], N_MOD, axis=-1)
        mc = jnp.split(silu_cc @ ada_w[l] + ada_b[l], N_MOD, axis=-1)
        lb_f, lb_b = lower[l, 0], lower[l, 1]
        px = modulate(x, mx[0], mx[1]) @ w_in[l]
        w_in_ctx = w_in[l][:, :HG_STATE_COLS] if last else w_in[l]
        pc = modulate(ctx, mc[0], mc[1]) @ w_in_ctx
        hg_x = hg_state_inputs(px[..., :HG_STATE_COLS], lb_f, lb_b)
        hg_c = hg_state_inputs(pc[..., :HG_STATE_COLS], lb_f, lb_b)
        v_c, kf_c, kb_c, lff_c, lfb_c = hg_c
        s_f = gla_final_state(kf_c, v_c, lff_c)
        s_b = gla_final_state(flip(kb_c), flip(v_c), flip(lfb_c))
        mix_args = (hg_norm_g[l], sc_conv_w[l], sg_ln_g[l], sg_ln_b[l], sg_w[l], sg_b[l])
        mix_x = token_mixers(px, hg_x, s_f, s_b, *mix_args)
        x_new = layer_norm(ALPHA * x + mx[2] * (mix_x @ w_out[l]), ln1_g[l], ln1_b[l])
        ffn_x = conv_ffn(modulate(x_new, mx[3], mx[4]), ffn_up[l], ffn_conv_w[l], ffn_conv_b[l], ffn_down[l], rows)
        x_new = layer_norm(ALPHA * x_new + mx[5] * ffn_x, ln2_g[l], ln2_b[l])
        if not last:
            zero = jnp.zeros_like(s_f)
            mix_c = token_mixers(pc, hg_c, zero, zero, *mix_args)
            ctx = layer_norm(ALPHA * ctx + mc[2] * (mix_c @ w_out[l]), ln1_g[l], ln1_b[l])
            ffn_c = conv_ffn(modulate(ctx, mc[3], mc[4]), ffn_up[l], ffn_conv_w[l], ffn_conv_b[l], ffn_down[l], 1)
            ctx = layer_norm(ALPHA * ctx + mc[5] * ffn_c, ln2_g[l], ln2_b[l])
        x = x_new
    return x
```

```cpp
#include <hip/hip_runtime.h>
#include <cstdio>
#include <cstdint>
namespace pg8 {
#define PG8_LAS __attribute__((address_space(3)))
typedef unsigned short bf16_t;
typedef short bf16x8 __attribute__((ext_vector_type(8)));
typedef float f32x4 __attribute__((ext_vector_type(4)));
typedef unsigned u32x4 __attribute__((ext_vector_type(4)));
constexpr int BM = 256, BK = 64, HALF = 128, HTB = HALF * BK * 2  , STAGE_BYTES = 8 * HTB, NXCD = 8, WGM = 8;

__host__ __device__ __forceinline__ int lds_byte(int r, int c) { const int st = (r >> 4) * 2 + (c >> 5), rr = r & 15, cc = c & 31, ob = rr * 64 + cc * 2; return st * 1024 + (ob ^ (((ob >> 9) & 1) << 5)); }
__host__ __device__ __forceinline__ void stage_rc(int b, int& R, int& C) { const int st = b / 1024, sb = b % 1024, swz = sb ^ (((sb >> 9) & 1) << 5); R = (st >> 1) * 16 + swz / 64; C = (st & 1) * 32 + (swz % 64) / 2; }
__host__ __device__ __forceinline__ int perm32(int rho) { const int n = rho >> 4, i = rho & 15; return 8 * (i >> 2) + 4 * n + (i & 3); }

struct Unit { int pm, pn; };
struct Gemm { const bf16_t* A; const bf16_t* Bt; int M, N, K; };

struct StaticOrder {
    int nM, nN, nwg, G, c;
    __host__ __device__ void init(int M, int N, int G_, int c_) { nM = M / BM; nN = N / BM; nwg = nM * nN; G = G_; c = c_; }
    __host__ __device__ bool next(int i, Unit& u) const {
        const long L = (long)i * G + c; if (L >= nwg) return false;
        int wgid = (int)L; { const int q = nwg / NXCD, r = nwg % NXCD, xcd = wgid % NXCD, off = wgid / NXCD; wgid = (xcd < r ? xcd * (q + 1) : r * (q + 1) + (xcd - r) * q) + off; }
        const int nig = WGM * nN, gid = wgid / nig, fm = gid * WGM, gsz = (nM - fm) < WGM ? (nM - fm) : WGM;
        u.pm = fm + ((wgid % nig) % gsz); u.pn = (wgid % nig) / gsz; return true;
    }
    __device__ __forceinline__ void a_ready(const Unit&) const {}
    __device__ __forceinline__ int arow(const Unit& u) const { return u.pm; }
    __device__ __forceinline__ void done(const Unit&) const {}
};

typedef __bf16 bf16x2v_ __attribute__((ext_vector_type(2)));
__device__ __forceinline__ unsigned cvt_pk_bf16(float lo, float hi) { typedef float f2_ __attribute__((ext_vector_type(2))); const f2_ v = {lo, hi}; return __builtin_bit_cast(unsigned, __builtin_convertvector(v, bf16x2v_)); }
typedef float f32x2 __attribute__((ext_vector_type(2)));
__device__ __forceinline__ f32x2 gelu_pk(f32x2 v) {
    const f32x2 av = __builtin_elementwise_abs(v), d = av * 0.2316418882f + 1.0f;
    f32x2 t; t.x = __builtin_amdgcn_rcpf(d.x); t.y = __builtin_amdgcn_rcpf(d.y);
    f32x2 q = t * 0.5307027145f + (-0.7265760135f); q = q * t + 0.7107068705f; q = q * t + (-0.142248368f); q = q * t + 0.127414796f; q = q * t;
    const f32x2 s = (v * v) * (-0.72134752044f);
    f32x2 e; e.x = __builtin_amdgcn_exp2f(s.x); e.y = __builtin_amdgcn_exp2f(s.y);
    const f32x2 m = v * (q * e), r = v - m;
    f32x2 o; o.x = v.x < 0.f ? m.x : r.x; o.y = v.y < 0.f ? m.y : r.y; return o;
}

template <int ACT  > struct EpiBf16 {
    static constexpr bool PERM = true, AFTER_DRAIN = false; static_assert(ACT == 0 || ACT == 1, "EpiBf16: ACT is 0 (none) or 1 (gelu_pk)");
    bf16_t* O; int ldc; const float* bias; int split_cols; size_t split_stride; float scale0;
    __device__ __forceinline__ void operator()(const f32x4 (&acc)[2][2][4][2], const Unit& u, int wr, int wc, int fr, int fq) const {
        const int row0 = u.pm * BM + wr * 64 + fr; int colt = u.pn * BM; bf16_t* base = O;
        float sc = 1.f; if (split_cols) { const int t = colt / split_cols; base += (size_t)t * split_stride; colt -= t * split_cols; if (t == 0) sc = scale0; }
        const int col0 = colt + wc * 32 + 8 * fq, bcol0 = u.pn * BM + wc * 32 + 8 * fq;
        f32x4 bv[2][2];
#pragma unroll
        for (int bj = 0; bj < 2; ++bj)
#pragma unroll
            for (int n = 0; n < 2; ++n) bv[bj][n] = bias ? *(const f32x4*)(bias + bcol0 + bj * HALF + 4 * n) : (f32x4){0.f, 0.f, 0.f, 0.f};
#pragma unroll
        for (int ai = 0; ai < 2; ++ai)
#pragma unroll
            for (int m = 0; m < 4; ++m) { bf16_t* rowp = base + (size_t)(row0 + ai * HALF + m * 16) * ldc + col0;
#pragma unroll
                for (int bj = 0; bj < 2; ++bj) { f32x4 v0 = acc[ai][bj][m][0] + bv[bj][0], v1 = acc[ai][bj][m][1] + bv[bj][1];
                    if (ACT == 1) { f32x2 a = gelu_pk((f32x2){v0[0], v0[1]}), b = gelu_pk((f32x2){v0[2], v0[3]}), c = gelu_pk((f32x2){v1[0], v1[1]}), d = gelu_pk((f32x2){v1[2], v1[3]});
                        v0 = (f32x4){a.x, a.y, b.x, b.y}; v1 = (f32x4){c.x, c.y, d.x, d.y}; }
                    v0 = v0 * sc; v1 = v1 * sc; u32x4 w; w.x = cvt_pk_bf16(v0[0], v0[1]); w.y = cvt_pk_bf16(v0[2], v0[3]); w.z = cvt_pk_bf16(v1[0], v1[1]); w.w = cvt_pk_bf16(v1[2], v1[3]);
                    *(u32x4*)(rowp + bj * HALF) = w; } }
    }
};
struct EpiF32 {
    static constexpr bool PERM = false, AFTER_DRAIN = false;
    float* C; int ldc; const float* bias;
    __device__ __forceinline__ void operator()(const f32x4 (&acc)[2][2][4][2], const Unit& u, int wr, int wc, int fr, int fq) const {
        const int row0 = u.pm * BM + wr * 64 + fr, col0 = u.pn * BM + wc * 32 + 4 * fq;
        f32x4 bv[2][2];
#pragma unroll
        for (int bj = 0; bj < 2; ++bj)
#pragma unroll
            for (int n = 0; n < 2; ++n) bv[bj][n] = bias ? *(const f32x4*)(bias + col0 + bj * HALF + n * 16) : (f32x4){0.f, 0.f, 0.f, 0.f};
#pragma unroll
        for (int ai = 0; ai < 2; ++ai)
#pragma unroll
            for (int m = 0; m < 4; ++m) { float* rowp = C + (size_t)(row0 + ai * HALF + m * 16) * ldc + col0;
#pragma unroll
                for (int bj = 0; bj < 2; ++bj)
#pragma unroll
                    for (int n = 0; n < 2; ++n) *(f32x4*)(rowp + bj * HALF + n * 16) = acc[ai][bj][m][n] + bv[bj][n]; }
    }
};
struct OrderJob {
    StaticOrder so; int split, off1, off2;
    __device__ void init(int nT, int nN, int G_, int c_, int split_, int off1_, int off2_) { so.init(nT * BM, nN * BM, G_, c_); split = split_; off1 = off1_; off2 = off2_; }
    __device__ bool next(int i, Unit& u) const { return so.next(i, u); }
    __device__ __forceinline__ void a_ready(const Unit&) const {}
    __device__ __forceinline__ void done(const Unit&) const {}
    __device__ __forceinline__ int arow(const Unit& u) const { return u.pm + (u.pm < split ? off1 : off2); }
};
struct OrderG1 {
    StaticOrder so; int nNc, G, c;
    __device__ void init(int G_, int c_, int nNc_) { so.init(64 * BM, 15 * BM, G_, c_); nNc = nNc_; G = G_; c = c_; }
    __device__ bool next(int i, Unit& u) const {
        const long L = (long)i * G + c;
        if (L < 960) return so.next(i, u);
        const int j = (int)L - 960; if (j >= 8 * nNc) return false;
        u.pm = 64 + (j & 7); u.pn = j >> 3; return true;
    }
    __device__ __forceinline__ void a_ready(const Unit&) const {}
    __device__ __forceinline__ void done(const Unit&) const {}
    __device__ __forceinline__ int arow(const Unit& u) const { return u.pm; }
};
struct EpiIn {
    static constexpr bool PERM = true, AFTER_DRAIN = false;
    bf16_t* PX; float* LF; const float* lbv;
    __device__ __forceinline__ void operator()(const f32x4 (&acc)[2][2][4][2], const Unit& u, int wr, int wc, int fr, int fq) const {
        const int row0 = u.pm * BM + wr * 64 + fr; const int pn = u.pn;
        const int cbase = pn * BM + wc * 32 + 8 * fq;
        if (pn >= 2 && pn < 6) {
            f32x4 lb0[2], lb1[2];
#pragma unroll
            for (int bj = 0; bj < 2; ++bj) { lb0[bj] = *(const f32x4*)(lbv + cbase - 512 + bj * HALF); lb1[bj] = *(const f32x4*)(lbv + cbase - 512 + bj * HALF + 4); }
#pragma unroll
            for (int ai = 0; ai < 2; ++ai)
#pragma unroll
                for (int m = 0; m < 4; ++m) { float* rowp = LF + (size_t)(row0 + ai * HALF + m * 16) * 1024 + (cbase - 512);
#pragma unroll
                    for (int bj = 0; bj < 2; ++bj) { f32x4 v0 = acc[ai][bj][m][0], v1 = acc[ai][bj][m][1], o0, o1;
#pragma unroll
                        for (int j = 0; j < 4; ++j) {
                            const float s0 = 1.f / (1.f + __expf(-v0[j])), s1 = 1.f / (1.f + __expf(-v1[j]));
                            o0[j] = __logf(fmaxf(lb0[bj][j] + (1.f - lb0[bj][j]) * s0, 1e-30f));
                            o1[j] = __logf(fmaxf(lb1[bj][j] + (1.f - lb1[bj][j]) * s1, 1e-30f)); }
                        *(f32x4*)(rowp + bj * HALF) = o0; *(f32x4*)(rowp + bj * HALF + 4) = o1; } }
        } else {
            const int pcol = (pn < 2) ? cbase : cbase - 1024;
            const int act = (pn == 6 || pn == 7) ? 1 : ((pn == 8 || pn == 9) ? 2 : 0);
            const float sc = (act == 1) ? 0.08838834764831845f : 1.f;
#pragma unroll
            for (int ai = 0; ai < 2; ++ai)
#pragma unroll
                for (int m = 0; m < 4; ++m) { bf16_t* rowp = PX + (size_t)(row0 + ai * HALF + m * 16) * 2816 + pcol;
#pragma unroll
                    for (int bj = 0; bj < 2; ++bj) { f32x4 v0 = acc[ai][bj][m][0], v1 = acc[ai][bj][m][1];
                        if (act) {
#pragma unroll
                            for (int j = 0; j < 4; ++j) { v0[j] = v0[j] * sc / (1.f + __expf(-v0[j])); v1[j] = v1[j] * sc / (1.f + __expf(-v1[j])); } }
                        u32x4 w; w.x = cvt_pk_bf16(v0[0], v0[1]); w.y = cvt_pk_bf16(v0[2], v0[3]); w.z = cvt_pk_bf16(v1[0], v1[1]); w.w = cvt_pk_bf16(v1[2], v1[3]);
                        *(u32x4*)(rowp + bj * HALF) = w; } }
        }
    }
};
template <class Epi, class Sched, bool ALIGN_EPI = false, bool SP2 = false>
__device__ __forceinline__ void gemm_phase(PG8_LAS unsigned char* lds, const Gemm g, const Sched& S, const Epi& E) {
    int tid_ = threadIdx.x; asm volatile("" : "+v"(tid_));
    const int tid = tid_, wid = __builtin_amdgcn_readfirstlane(tid >> 6), lane = tid & 63, wr = wid >> 2, wc = wid & 3, fr = lane & 15, fq = lane >> 4;
    const int K = g.K, nt = K / BK;
    unsigned voffA[2], voffB[2];
#pragma unroll
    for (int i = 0; i < 2; ++i) { int R, C; stage_rc(tid * 16 + i * 8192, R, C); const int Rb = Epi::PERM ? ((R & ~31) + perm32(R & 31)) : R;
        voffA[i] = (unsigned)(R * K + C) * 2u; voffB[i] = (unsigned)(Rb * K + C) * 2u; }
    const size_t kstep = (size_t)(BK * 2);
    const size_t hstep = (size_t)HALF * K * 2;
    const size_t tstep = 2 * hstep;
    const unsigned ldsw = (unsigned)wid * 1024u;
    const int aoff = lds_byte(wr * 64 + fr, fq * 8), boff = lds_byte(wc * 32 + fr, fq * 8);
#define PG8_SA(b, h) (((b) * 2 + (h)) * HTB)
#define PG8_SB(b, h) ((4 + (b) * 2 + (h)) * HTB)
#define PG8_STAGE(bufoff, gbase, voff) do { _Pragma("unroll") for (int _i = 0; _i < 2; ++_i) \
        __builtin_amdgcn_global_load_lds((const unsigned*)((const char*)(gbase) + (voff)[_i]), (PG8_LAS unsigned*)(lds + (bufoff) + ldsw + _i * 8192), 16, 0, 0); } while (0)
#define PG8_LDA(dst, b, h) do { _Pragma("unroll") for (int m = 0; m < 4; ++m) _Pragma("unroll") for (int k = 0; k < 2; ++k) dst[m][k] = *(const PG8_LAS bf16x8*)(lds + PG8_SA(b, h) + aoff + m * 2048 + k * 1024); } while (0)
#define PG8_LDB(dst, b, h) do { _Pragma("unroll") for (int n = 0; n < 2; ++n) _Pragma("unroll") for (int k = 0; k < 2; ++k) dst[n][k] = *(const PG8_LAS bf16x8*)(lds + PG8_SB(b, h) + boff + n * 2048 + k * 1024); } while (0)
#define PG8_MMA(ai, bj, At, Bt) do { __builtin_amdgcn_s_setprio(1); _Pragma("unroll") for (int m = 0; m < 4; ++m) _Pragma("unroll") for (int n = 0; n < 2; ++n) _Pragma("unroll") for (int k = 0; k < 2; ++k) \
        acc[ai][bj][m][n] = __builtin_amdgcn_mfma_f32_16x16x32_bf16(Bt[n][k], At[m][k], acc[ai][bj][m][n], 0, 0, 0); __builtin_amdgcn_s_setprio(0); } while (0)
#define PG8_WAIT_V(n) asm volatile("s_waitcnt vmcnt(" #n ")" ::: "memory")
#define PG8_WAIT_L(n) asm volatile("s_waitcnt lgkmcnt(" #n ")" ::: "memory")
#define PG8_BAR __builtin_amdgcn_s_barrier()
#define PG8_SCHED __builtin_amdgcn_sched_barrier(0)
    Unit cur, nxt; int ui = 0;
    if (!S.next(0, cur)) return;
    f32x4 acc[2][2][4][2];
#pragma unroll
    for (int a = 0; a < 2; ++a)
#pragma unroll
        for (int b = 0; b < 2; ++b)
#pragma unroll
            for (int m = 0; m < 4; ++m)
#pragma unroll
                for (int n = 0; n < 2; ++n) acc[a][b][m][n] = (f32x4){0.f, 0.f, 0.f, 0.f};
    bf16x8 At[4][2], B0[2][2], B1[2][2];
    const char* cA = (const char*)g.A + (size_t)S.arow(cur) * tstep; const char* cB = (const char*)g.Bt + (size_t)cur.pn * tstep;
    S.a_ready(cur);
    if constexpr (SP2) {
        PG8_STAGE(PG8_SB(0, 0), cB, voffB); PG8_STAGE(PG8_SB(0, 1), cB + hstep, voffB); PG8_STAGE(PG8_SA(0, 0), cA, voffA); PG8_STAGE(PG8_SA(0, 1), cA + hstep, voffA);
        if (wr == 1) PG8_BAR;
        PG8_WAIT_V(2); PG8_BAR;
        PG8_STAGE(PG8_SB(1, 0), cB + kstep, voffB); PG8_STAGE(PG8_SA(1, 0), cA + kstep, voffA); PG8_STAGE(PG8_SB(1, 1), cB + hstep + kstep, voffB);
        PG8_WAIT_V(6); PG8_BAR;
    } else {
        PG8_STAGE(PG8_SB(0, 0), cB, voffB); PG8_STAGE(PG8_SA(0, 0), cA, voffA); PG8_STAGE(PG8_SB(0, 1), cB + hstep, voffB); PG8_STAGE(PG8_SA(0, 1), cA + hstep, voffA);
        if (wr == 1) PG8_BAR;
        PG8_WAIT_V(4); PG8_BAR;
        PG8_STAGE(PG8_SB(1, 0), cB + kstep, voffB); PG8_STAGE(PG8_SA(1, 0), cA + kstep, voffA); PG8_STAGE(PG8_SB(1, 1), cB + hstep + kstep, voffB);
        PG8_WAIT_V(6); PG8_BAR;
    }
    for (;;) {
        const bool has_next = S.next(ui + 1, nxt);
        const char* nA = has_next ? (const char*)g.A + (size_t)S.arow(nxt) * tstep : cA; const char* nB = has_next ? (const char*)g.Bt + (size_t)nxt.pn * tstep : cB;
        for (int t = 0; t < nt; t += 2) {
            const bool last = (t == nt - 2);
            const char* a1 = cA + (size_t)(t + 1) * kstep;
            const char* a2 = last ? nA : cA + (size_t)(t + 2) * kstep; const char* b2 = last ? nB : cB + (size_t)(t + 2) * kstep;
            const char* a3 = a2 + kstep; const char* b3 = b2 + kstep;
            if (last && has_next) S.a_ready(nxt);
            if constexpr (SP2) {
            PG8_LDB(B0, 0, 0); PG8_LDB(B1, 0, 1); PG8_SCHED; PG8_LDA(At, 0, 0); PG8_STAGE(PG8_SA(1, 1), a1 + hstep, voffA);
            PG8_WAIT_V(8); PG8_WAIT_L(0); PG8_BAR; PG8_MMA(0, 0, At, B0); PG8_MMA(0, 1, At, B1); PG8_BAR; PG8_SCHED;
            PG8_LDA(At, 0, 1); PG8_STAGE(PG8_SB(0, 0), b2, voffB); PG8_STAGE(PG8_SB(0, 1), b2 + hstep, voffB); PG8_STAGE(PG8_SA(0, 0), a2, voffA);
            PG8_WAIT_V(8); PG8_WAIT_L(0); PG8_BAR; PG8_MMA(1, 0, At, B0); PG8_MMA(1, 1, At, B1); PG8_BAR; PG8_SCHED;
            PG8_LDB(B0, 1, 0); PG8_LDB(B1, 1, 1); PG8_SCHED; PG8_LDA(At, 1, 0); PG8_STAGE(PG8_SA(0, 1), a2 + hstep, voffA);
            PG8_WAIT_V(8); PG8_WAIT_L(0); PG8_BAR; PG8_MMA(0, 0, At, B0); PG8_MMA(0, 1, At, B1); PG8_BAR; PG8_SCHED;
            PG8_LDA(At, 1, 1); PG8_STAGE(PG8_SB(1, 0), b3, voffB); PG8_STAGE(PG8_SB(1, 1), b3 + hstep, voffB); PG8_STAGE(PG8_SA(1, 0), a3, voffA);
            PG8_WAIT_V(8); PG8_WAIT_L(0); PG8_BAR; PG8_MMA(1, 0, At, B0); PG8_MMA(1, 1, At, B1); PG8_BAR; PG8_SCHED;
            } else {
            PG8_LDB(B0, 0, 0); PG8_SCHED; PG8_LDA(At, 0, 0); PG8_STAGE(PG8_SA(1, 1), a1 + hstep, voffA);
            PG8_WAIT_L(8); PG8_BAR; PG8_WAIT_L(0); PG8_MMA(0, 0, At, B0); PG8_BAR; PG8_SCHED;
            PG8_LDB(B1, 0, 1); PG8_STAGE(PG8_SB(0, 0), b2, voffB);
            PG8_BAR; PG8_WAIT_L(0); PG8_MMA(0, 1, At, B1); PG8_BAR;
            PG8_LDA(At, 0, 1); PG8_STAGE(PG8_SA(0, 0), a2, voffA);
            PG8_BAR; PG8_WAIT_L(0); PG8_MMA(1, 0, At, B0); PG8_BAR; PG8_SCHED;
            PG8_STAGE(PG8_SB(0, 1), b2 + hstep, voffB);
            PG8_WAIT_V(6); PG8_BAR; PG8_MMA(1, 1, At, B1); PG8_BAR;
            PG8_LDB(B0, 1, 0); PG8_SCHED; PG8_LDA(At, 1, 0); PG8_STAGE(PG8_SA(0, 1), a2 + hstep, voffA);
            PG8_WAIT_L(8); PG8_BAR; PG8_WAIT_L(0); PG8_MMA(0, 0, At, B0); PG8_BAR; PG8_SCHED;
            PG8_LDB(B1, 1, 1); PG8_STAGE(PG8_SB(1, 0), b3, voffB);
            PG8_BAR; PG8_WAIT_L(0); PG8_MMA(0, 1, At, B1); PG8_BAR;
            PG8_LDA(At, 1, 1); PG8_STAGE(PG8_SA(1, 0), a3, voffA);
            PG8_BAR; PG8_WAIT_L(0); PG8_MMA(1, 0, At, B0); PG8_BAR; PG8_SCHED;
            PG8_STAGE(PG8_SB(1, 1), b3 + hstep, voffB);
            PG8_WAIT_V(6); PG8_BAR; PG8_MMA(1, 1, At, B1); PG8_BAR;
            }
        }
        if constexpr (ALIGN_EPI) { if (wr == 0) PG8_BAR; }
        if constexpr (!Epi::AFTER_DRAIN) { E(acc, cur, wr, wc, fr, fq); S.done(cur); }
        if (!has_next) break;
#pragma unroll
        for (int a = 0; a < 2; ++a)
#pragma unroll
            for (int b = 0; b < 2; ++b)
#pragma unroll
                for (int m = 0; m < 4; ++m)
#pragma unroll
                    for (int n = 0; n < 2; ++n) acc[a][b][m][n] = (f32x4){0.f, 0.f, 0.f, 0.f};
        cur = nxt; cA = nA; cB = nB; ++ui;
        if constexpr (ALIGN_EPI) { if (wr == 1) PG8_BAR; }
    }
    PG8_WAIT_V(0);
    if constexpr (!ALIGN_EPI) { if (wr == 0) PG8_BAR; }
    PG8_BAR;
    if constexpr (Epi::AFTER_DRAIN) { E.fused(acc, cur, wr, wc, fr, fq, lds, wid, lane); S.done(cur); }
#undef PG8_SA
#undef PG8_SB
#undef PG8_STAGE
#undef PG8_LDA
#undef PG8_LDB
#undef PG8_MMA
#undef PG8_WAIT_V
#undef PG8_WAIT_L
#undef PG8_BAR
#undef PG8_SCHED
}
}
constexpr int NWAVES = 8;
constexpr int DM = 1024, NB = 8, SEQ = 2048, CTXL = 256, MX = NB * SEQ, MC = NB * CTXL, MT = MX + MC;
constexpr int INC = 3840, DFF = 2816, PXW = 2816, NMODC = 6 * DM;
constexpr float LN_EPS = 1e-6f, ALPHA = 1.4142135623730951f;
constexpr int PXC_V = 0, PXC_Q = 512, PXC_G = 1024, PXC_GB = 1536, PXC_GC = 1792, PXC_HS = 2048, PXC_U = 2304, PXC_VS = 2560;

constexpr size_t MiB = 1u << 20;
constexpr size_t WS_CTL = 0, CTL_ZERO_BYTES = 512 * 1024;
constexpr size_t WS_MOD = 512 * 1024;
constexpr size_t WS_LBV = WS_MOD + 448 * 1024;
constexpr size_t WS_WIN = 1 * MiB, WS_WOUT = WS_WIN + (size_t)INC * DM * 2, WS_WUP = WS_WOUT + (size_t)DM * DM * 2, WS_WDN = WS_WUP + (size_t)2 * DFF * DM * 2;
constexpr size_t WS_XM = 27 * MiB;
constexpr size_t WS_PX = 63 * MiB;
constexpr size_t WS_LF = 162 * MiB;
constexpr size_t WS_OB = 234 * MiB;
constexpr size_t WS_CTXR = 248 * MiB;
constexpr size_t WS_END = 256 * MiB;
static_assert(WS_WDN + (size_t)DM * DFF * 2 <= WS_XM && WS_XM + (size_t)MT * DM * 2 <= WS_PX && WS_PX + (size_t)MT * PXW * 2 <= WS_LF && WS_LF + (size_t)MT * DM * 4 <= WS_OB && WS_OB + (size_t)MT * 512 * 2 <= WS_END && WS_CTXR + (size_t)MC * DM * 4 <= WS_END, "ws map");
static_assert(WS_PX + 2 * (size_t)MX * DFF * 2 <= WS_END, "A_buf|G_buf for 16384 rows (layer 1: LF, OB, CTXR are dead then)");
constexpr int CW_BAR = 4096;

constexpr int RING_OFF = 0, RING_BYTES = 131072;
constexpr int LDSCTL_OFF = RING_BYTES, MISC_OFF = LDSCTL_OFF + 320;
constexpr int LDS_BYTES = 147456;
#define GAS __attribute__((address_space(1)))
#define LAS __attribute__((address_space(3)))
typedef unsigned short bf16;
typedef unsigned v4u __attribute__((ext_vector_type(4)));
typedef float f32x4 __attribute__((ext_vector_type(4)));
typedef short bf16x8 __attribute__((ext_vector_type(8)));
typedef GAS unsigned gu32;
typedef GAS unsigned long long gu64;
#define RLX_AGENT __ATOMIC_RELAXED, __HIP_MEMORY_SCOPE_AGENT
#define LDS_WAIT() asm volatile("s_waitcnt lgkmcnt(0)" ::: "memory")
#define VM_WAIT() asm volatile("s_waitcnt vmcnt(0)" ::: "memory")
__device__ __forceinline__ unsigned long long rt() { return __builtin_amdgcn_s_memrealtime(); }
__device__ __forceinline__ unsigned f2bf(float f) { unsigned u = __builtin_bit_cast(unsigned, f); return (u + 0x7fffu + ((u >> 16) & 1u)) >> 16; }
__device__ __forceinline__ unsigned pk2(float lo, float hi) { return f2bf(lo) | (f2bf(hi) << 16); }

#define XB_TMO      128
#define XB_XCNT(j)  (256  + 64 * (j))
#define XB_XSUB(j)  (1280 + 64 * (j))
#define XB_XGEN(j)  (2304 + 64 * (j))
#define XB_TOP      3328
#define XB_TOPGEN   3392
#define XCD_BAR_WORDS 3456
#define XB_SPIN_CAP (1u << 28)

__device__ __forceinline__ unsigned xb_ld(unsigned* p)              { return __hip_atomic_load(p, __ATOMIC_RELAXED, __HIP_MEMORY_SCOPE_AGENT); }
__device__ __forceinline__ unsigned xb_add(unsigned* p, unsigned v) { return __hip_atomic_fetch_add(p, v, __ATOMIC_RELAXED, __HIP_MEMORY_SCOPE_AGENT); }
__device__ __forceinline__ unsigned xb_xcc_id() { return (unsigned)__builtin_amdgcn_s_getreg((3 << 11) | 20) & 0xFu; }
#define XB_SPIN(cond, bar) do { unsigned _sp = 0; while (cond) { __builtin_amdgcn_s_sleep(1); \
    if ((++_sp & 255u) == 0u) { if (xb_ld(&(bar)[XB_TMO])) break; if (_sp > XB_SPIN_CAP) { atomicAdd(&(bar)[XB_TMO], 1u); break; } } } } while (0)

struct XcdBarrier {
    unsigned* bar; unsigned x;
    volatile LAS unsigned* st;
};

__device__ __forceinline__ XcdBarrier xcd_barrier_post(unsigned* bar, volatile LAS unsigned* st) {
    XcdBarrier b; b.bar = bar; b.x = xb_xcc_id(); b.st = st;
    if (threadIdx.x == 0) (void)xb_add(&bar[XB_XCNT(b.x)], 1u);
    return b;
}
__device__ __forceinline__ void xcd_barrier_complete(unsigned* bar, unsigned x, unsigned& nloc, unsigned& nx) {
    const unsigned G = gridDim.x * gridDim.y * gridDim.z;
    unsigned sum, cnt, mine, sp = 0u;
    for (;;) {
        sum = 0u; cnt = 0u; mine = 0u;
#pragma unroll
        for (unsigned j = 0; j < 16; ++j) { const unsigned c = xb_ld(&bar[XB_XCNT(j)]); sum += c; cnt += (c > 0u) ? 1u : 0u; mine = (j == x) ? c : mine; }
        if (sum == G) break;
        __builtin_amdgcn_s_sleep(1);
        if ((++sp & 255u) == 0u) { if (xb_ld(&bar[XB_TMO])) break; if (sp > XB_SPIN_CAP) { atomicAdd(&bar[XB_TMO], 1u); break; } }
    }
    nloc = mine > 0u ? mine : 1u; nx = cnt > 0u ? cnt : 1u;
}

__device__ __forceinline__ void xcd_barrier(const XcdBarrier& b) {
    asm volatile("s_waitcnt vmcnt(0)" ::: "memory");
    __syncthreads();
    if (threadIdx.x == 0) {
        unsigned* bar = b.bar;
        __builtin_amdgcn_s_waitcnt(0);
        unsigned nloc = b.st[0], nx = b.st[1];
        if (nloc == 0u) { xcd_barrier_complete(bar, b.x, nloc, nx); b.st[0] = nloc; b.st[1] = nx; }
        const unsigned old = xb_add(&bar[XB_XSUB(b.x)], 1u);
        const unsigned gen = old / nloc;
        if (old + 1u == (gen + 1u) * nloc) {
            __builtin_amdgcn_fence(__ATOMIC_RELEASE, "agent");
            asm volatile("s_waitcnt vmcnt(0)" ::: "memory");
            const unsigned og = xb_add(&bar[XB_TOP], 1u);
            const unsigned tg = og / nx;
            if (og + 1u == (tg + 1u) * nx) xb_add(&bar[XB_TOPGEN], 1u);
            else XB_SPIN(xb_ld(&bar[XB_TOPGEN]) == tg, bar);
            __builtin_amdgcn_fence(__ATOMIC_ACQUIRE, "agent");
            xb_add(&bar[XB_XGEN(b.x)], 1u);
            asm volatile("s_waitcnt vmcnt(0)" ::: "memory");
        } else {
            XB_SPIN(xb_ld(&bar[XB_XGEN(b.x)]) == gen, bar);
            __builtin_amdgcn_fence(__ATOMIC_ACQUIRE, "agent");
            asm volatile("s_waitcnt vmcnt(0)" ::: "memory");
        }
    }
    __syncthreads();
}

struct Frame {
    LAS unsigned char* lds;
    volatile LAS unsigned* MISC;
    gu32* ctl;
    int tid, lane, wave, vcu, G;
    float* out;
    unsigned char* ws;
};
__device__ __forceinline__ const float* inptr(int i) { asm volatile("" : "+s"(i)); return *(const float* const*)((const char __attribute__((address_space(4)))*)__builtin_amdgcn_kernarg_segment_ptr() + 8 * i); }
#define IN_X inptr(0)
#define IN_C inptr(1)
#define IN_CTX inptr(2)
#define IN_C_CTX inptr(3)
#define IN_ADA_W inptr(4)
#define IN_ADA_B inptr(5)
#define IN_W_IN inptr(6)
#define IN_HG_LB inptr(7)
#define IN_HG_NORM_G inptr(8)
#define IN_SC_CONV_W inptr(9)
#define IN_SG_LN_G inptr(10)
#define IN_SG_LN_B inptr(11)
#define IN_SG_W inptr(12)
#define IN_SG_B inptr(13)
#define IN_W_OUT inptr(14)
#define IN_LN1_G inptr(15)
#define IN_LN1_B inptr(16)
#define IN_FFN_UP inptr(17)
#define IN_FFN_CONV_W inptr(18)
#define IN_FFN_CONV_B inptr(19)
#define IN_FFN_DOWN inptr(20)
#define IN_LN2_G inptr(21)
#define IN_LN2_B inptr(22)
typedef float f32x2 __attribute__((ext_vector_type(2)));
typedef unsigned u32x2 __attribute__((ext_vector_type(2)));
#define WGBAR() do { asm volatile("s_waitcnt vmcnt(0) lgkmcnt(0)" ::: "memory"); __builtin_amdgcn_s_barrier(); asm volatile("" ::: "memory"); } while (0)
#define LBAR() do { asm volatile("s_waitcnt lgkmcnt(0)" ::: "memory"); __builtin_amdgcn_s_barrier(); asm volatile("" ::: "memory"); } while (0)
__device__ __forceinline__ float wave_sum(float v) {
#pragma unroll
    for (int o = 1; o < 64; o <<= 1) v += __shfl_xor(v, o);
    return v;
}
__device__ __forceinline__ unsigned cvtpk(float lo, float hi) { return pg8::cvt_pk_bf16(lo, hi); }
__device__ __forceinline__ float bflo(unsigned u) { return __uint_as_float(u << 16); }
__device__ __forceinline__ float bfhi(unsigned u) { return __uint_as_float(u & 0xffff0000u); }
__device__ __forceinline__ float bf1(unsigned short u) { return __uint_as_float(((unsigned)u) << 16); }
__device__ __forceinline__ float siluf(float v) { return v / (1.f + __expf(-v)); }

__device__ __forceinline__ void p0_transpose_item(const float* W, int K, int N, bf16* WT, LAS float* scr, int item, int lane) {
    const int nblk = N / 32, kb = item / nblk, nb = item % nblk, k0 = 64 * kb, n0 = 32 * nb;
#pragma unroll 8
    for (int i = 0; i < 32; ++i) { const int kk = 2 * i + (lane >> 5); scr[kk * 33 + (lane & 31)] = W[(size_t)(k0 + kk) * N + n0 + (lane & 31)]; }
    LDS_WAIT(); asm volatile("" ::: "memory");
    const int c = lane & 7;
#pragma unroll
    for (int j = 0; j < 4; ++j) { const int n = (lane >> 3) + 8 * j; const LAS float* s = scr + (8 * c) * 33 + n;
        v4u o; o.x = pk2(s[0 * 33], s[1 * 33]); o.y = pk2(s[2 * 33], s[3 * 33]); o.z = pk2(s[4 * 33], s[5 * 33]); o.w = pk2(s[6 * 33], s[7 * 33]);
        *(GAS v4u*)(WT + (size_t)(n0 + n) * K + k0 + 8 * c) = o; }
    LDS_WAIT(); asm volatile("" ::: "memory");
}
__device__ __forceinline__ void convert_weights(Frame& F, int layer, int which) {
    LAS float* scr = (LAS float*)(F.lds + RING_OFF + F.wave * 16384);
    const int gw = F.vcu * NWAVES + F.wave, NGW = F.G * NWAVES;
    const float* const p_win = IN_W_IN; const float* const p_wout = IN_W_OUT; const float* const p_up = IN_FFN_UP; const float* const p_dn = IN_FFN_DOWN;
    constexpr int I_IN = (DM / 64) * (INC / 32), I_OUT = (DM / 64) * (DM / 32), I_UP = (DM / 64) * (2 * DFF / 32), I_DN = (DFF / 64) * (DM / 32);
    if (which & 1) {
        for (int it = gw; it < I_IN + I_OUT; it += NGW) {
            if (it < I_IN) p0_transpose_item(p_win + (size_t)layer * DM * INC, DM, INC, (bf16*)(F.ws + WS_WIN), scr, it, F.lane);
            else p0_transpose_item(p_wout + (size_t)layer * DM * DM, DM, DM, (bf16*)(F.ws + WS_WOUT), scr, it - I_IN, F.lane);
        }
    }
    if (which & 2) {
        for (int it = gw; it < I_UP + I_DN; it += NGW) {
            if (it < I_UP) p0_transpose_item(p_up + (size_t)layer * DM * 2 * DFF, DM, 2 * DFF, (bf16*)(F.ws + WS_WUP), scr, it, F.lane);
            else p0_transpose_item(p_dn + (size_t)layer * DFF * DM, DFF, DM, (bf16*)(F.ws + WS_WDN), scr, it - I_UP, F.lane);
        }
    }
}
__device__ __forceinline__ void p0_mod(Frame& F) {
    LAS float* sc = (LAS float*)(F.lds);
    LAS float* red = (LAS float*)(F.lds + 40960);
    float* mod = (float*)(F.ws + WS_MOD);
    const float* const p_c = IN_C; const float* const p_cc = IN_C_CTX; const float* const p_aw = IN_ADA_W; const float* const p_ab = IN_ADA_B; const float* const p_lb = IN_HG_LB;
    for (int idx = F.tid; idx < 9 * 1024; idx += 512) { const int r = idx >> 10, k = idx & 1023; const float v = r < 8 ? p_c[r * 1024 + k] : p_cc[k]; sc[idx] = siluf(v); }
    WGBAR();
    for (int item = F.vcu; item < 192; item += F.G) {
        const int l = item / 96, n0 = (item % 96) * 64;
        const float* W = p_aw + (size_t)l * DM * NMODC + n0 + F.lane; const int k0 = F.wave * 128;
        float acc[9];
#pragma unroll
        for (int r = 0; r < 9; ++r) acc[r] = 0.f;
        for (int k = k0; k < k0 + 128; k += 8) {
            float wv[8];
#pragma unroll
            for (int i = 0; i < 8; ++i) wv[i] = W[(size_t)(k + i) * NMODC];
#pragma unroll
            for (int i = 0; i < 8; ++i)
#pragma unroll
                for (int r = 0; r < 9; ++r) acc[r] += sc[r * 1024 + k + i] * wv[i];
        }
#pragma unroll
        for (int r = 0; r < 9; ++r) red[(F.wave * 9 + r) * 64 + F.lane] = acc[r];
        WGBAR();
        for (int o = F.tid; o < 576; o += 512) { const int r = o >> 6, col = o & 63; float s = 0.f;
#pragma unroll
            for (int w = 0; w < 8; ++w) s += red[(w * 9 + r) * 64 + col];
            mod[(size_t)(l * 9 + r) * NMODC + n0 + col] = s + p_ab[l * NMODC + n0 + col]; }
        WGBAR();
    }
    if (F.vcu == F.G - 1) { float* lbv = (float*)(F.ws + WS_LBV);
        for (int i = F.tid; i < 1024; i += 512) { lbv[i] = 0.f; lbv[1024 + i] = 1.f / (1.f + __expf(-(p_lb[1024 + i] - p_lb[i]))); } }
}
__device__ __forceinline__ void row_stats(const f32x4 (&v)[4], float& mean, float& rstd) {
    float s = 0.f;
#pragma unroll
    for (int j = 0; j < 4; ++j) s += (v[j].x + v[j].y) + (v[j].z + v[j].w);
    mean = wave_sum(s) * (1.f / DM); float s2 = 0.f;
#pragma unroll
    for (int j = 0; j < 4; ++j) { const f32x4 d = v[j] - mean; s2 += (d.x * d.x + d.y * d.y) + (d.z * d.z + d.w * d.w); }
    rstd = 1.f / sqrtf(wave_sum(s2) * (1.f / DM) + LN_EPS);
}
__device__ __forceinline__ void modulate_store(const f32x4 (&v)[4], const float* shift, const float* scale, bf16* orow, int lane) {
    float mean, rstd; row_stats(v, mean, rstd);
#pragma unroll
    for (int j = 0; j < 4; ++j) { const f32x4 sh = *(const f32x4*)(shift + 4 * lane + 256 * j), sc = *(const f32x4*)(scale + 4 * lane + 256 * j);
        const f32x4 y = (v[j] - mean) * rstd * (sc + 1.f) + sh; u32x2 w; w.x = cvtpk(y.x, y.y); w.y = cvtpk(y.z, y.w);
        *(u32x2*)(orow + 4 * lane + 256 * j) = w; }
}
__device__ __forceinline__ const float* mod_row(Frame& F, int layer, int row) { return (const float*)(F.ws + WS_MOD) + (size_t)(layer * 9 + (row < MX ? row / SEQ : 8)) * NMODC; }
__device__ __forceinline__ void phase_r1(Frame& F) {
    const int gw = F.vcu * NWAVES + F.wave, NGW = F.G * NWAVES; bf16* XM = (bf16*)(F.ws + WS_XM); const float* const p_x = IN_X; const float* const p_ctx = IN_CTX;
    for (int row = gw; row < MT; row += NGW) {
        const float* src = row < MX ? p_x + (size_t)row * DM : p_ctx + (size_t)(row - MX) * DM; const float* md = mod_row(F, 0, row);
        f32x4 v[4];
#pragma unroll
        for (int j = 0; j < 4; ++j) v[j] = *(const f32x4*)(src + 4 * F.lane + 256 * j);
        modulate_store(v, md, md + DM, XM + (size_t)row * DM, F.lane);
    }
}
__device__ __forceinline__ void phase_r2(Frame& F, int layer) {
    const int gw = F.vcu * NWAVES + F.wave, NGW = F.G * NWAVES; bf16* XM = (bf16*)(F.ws + WS_XM); const float* Y = (const float*)(F.ws + WS_LF);
    const int nrows = layer == 0 ? MT : MX; const float* g1 = IN_LN1_G + layer * DM; const float* b1 = IN_LN1_B + layer * DM; const float* const p_x = IN_X; const float* const p_ctx = IN_CTX;
    for (int row = gw; row < nrows; row += NGW) {
        const float* res = layer == 0 ? (row < MX ? p_x + (size_t)row * DM : p_ctx + (size_t)(row - MX) * DM) : F.out + (size_t)row * DM;
        float* dst = row < MX ? F.out + (size_t)row * DM : (float*)(F.ws + WS_CTXR) + (size_t)(row - MX) * DM;
        const float* md = mod_row(F, layer, row);
        f32x4 v[4];
#pragma unroll
        for (int j = 0; j < 4; ++j) { const int o = 4 * F.lane + 256 * j; const f32x4 r = *(const f32x4*)(res + o), y = *(const f32x4*)(Y + (size_t)row * DM + o), g = *(const f32x4*)(md + 2 * DM + o); v[j] = r * ALPHA + g * y; }
        float mean, rstd; row_stats(v, mean, rstd);
#pragma unroll
        for (int j = 0; j < 4; ++j) { const int o = 4 * F.lane + 256 * j; v[j] = (v[j] - mean) * rstd * *(const f32x4*)(g1 + o) + *(const f32x4*)(b1 + o); *(f32x4*)(dst + o) = v[j]; }
        modulate_store(v, md + 3 * DM, md + 4 * DM, XM + (size_t)row * DM, F.lane);
    }
}
__device__ __forceinline__ void phase_r3(Frame& F, int layer, int nT, int split, int off1, int off2) {
    const int gw = F.vcu * NWAVES + F.wave, NGW = F.G * NWAVES; bf16* XM = (bf16*)(F.ws + WS_XM); const float* Y2 = (const float*)(F.ws + WS_PX);
    const float* g2 = IN_LN2_G + layer * DM; const float* b2 = IN_LN2_B + layer * DM;
    for (int cr = gw; cr < nT * 256; cr += NGW) {
        const int ci = cr >> 8, row = ((ci + (ci < split ? off1 : off2)) << 8) + (cr & 255);
        float* xr = row < MX ? F.out + (size_t)row * DM : (float*)(F.ws + WS_CTXR) + (size_t)(row - MX) * DM;
        const float* md = mod_row(F, layer, row);
        f32x4 v[4];
#pragma unroll
        for (int j = 0; j < 4; ++j) { const int o = 4 * F.lane + 256 * j; const f32x4 r = *(const f32x4*)(xr + o), y = *(const f32x4*)(Y2 + (size_t)cr * DM + o), g = *(const f32x4*)(md + 5 * DM + o); v[j] = r * ALPHA + g * y; }
        float mean, rstd; row_stats(v, mean, rstd);
#pragma unroll
        for (int j = 0; j < 4; ++j) { const int o = 4 * F.lane + 256 * j; v[j] = (v[j] - mean) * rstd * *(const f32x4*)(g2 + o) + *(const f32x4*)(b2 + o); if (row < MX) *(f32x4*)(xr + o) = v[j]; }
        if (layer == 0) { const float* md1 = mod_row(F, 1, row); modulate_store(v, md1, md1 + DM, XM + (size_t)row * DM, F.lane); }
    }
}
#define MFMA16(a, b, c) __builtin_amdgcn_mfma_f32_16x16x32_bf16((a), (b), (c), 0, 0, 0)
constexpr int HG_QP = 0, HG_KP = 17408, HG_KT = 34816, HG_VT = 53248, HG_ST = 71680, HG_AS = 106496, HG_T = 115712, HG_CV = 119808, HG_END = 121344;
static_assert(HG_END <= RING_BYTES, "hgrn lds");
__device__ __forceinline__ void hgrn_scan(Frame& F, int layer, int item) {
    const int b = item >> 3, h = (item >> 1) & 3, dir = item & 1;
    LAS unsigned char* L = F.lds;
    const int lane = F.lane, w = F.wave, l15 = lane & 15, lq = lane >> 4;
    const float* LFp = (const float*)(F.ws + WS_LF) + dir * 512 + h * 128 + 2 * lane;
    const bf16* PX = (const bf16*)(F.ws + WS_PX);
    const bf16* Qp = PX + PXC_Q + h * 128 + 2 * lane;
    const bf16* Vp = PX + PXC_V + h * 128 + 2 * lane;
    bf16* Of = (bf16*)(F.ws + WS_XM);
    bf16* Ob = (bf16*)(F.ws + WS_OB);
    f32x4 S[8];
#pragma unroll
    for (int i = 0; i < 8; ++i) S[i] = (f32x4){0.f, 0.f, 0.f, 0.f};
    f32x2 lf[8]; unsigned qv[8], vv[8];
#define HG_BASE(s) ((s) < 4 ? MX + b * CTXL + (dir ? 3 - (s) : (s)) * 64 : b * SEQ + (dir ? 35 - (s) : (s) - 4) * 64)
#define HG_LOAD(s) do { const int base_ = HG_BASE(s); const bool wq_ = ((s) >= 4) || layer == 0; \
        _Pragma("unroll") for (int r = 0; r < 8; ++r) { const int row_ = base_ + (dir ? 63 - 8 * w - r : 8 * w + r); \
            lf[r] = *(const f32x2*)(LFp + (size_t)row_ * 1024); vv[r] = *(const unsigned*)(Vp + (size_t)row_ * PXW); } \
        if (wq_) { _Pragma("unroll") for (int r = 0; r < 8; ++r) { const int row_ = base_ + (dir ? 63 - 8 * w - r : 8 * w + r); qv[r] = *(const unsigned*)(Qp + (size_t)row_ * PXW); } } \
        else { _Pragma("unroll") for (int r = 0; r < 8; ++r) qv[r] = 0u; } } while (0)
    HG_LOAD(0);
    for (int s = 0; s < 36; ++s) {
        const int base = HG_BASE(s); const bool wanto = (s >= 4) || layer == 0;
        f32x2 cs[8]; f32x2 run = (f32x2){0.f, 0.f};
#pragma unroll
        for (int r = 0; r < 8; ++r) { run = run + lf[r]; cs[r] = run; }
        *(LAS f32x2*)(L + HG_T + (w * 128 + 2 * lane) * 4) = run;
        LBAR();
        f32x2 P = (f32x2){0.f, 0.f}, mm = P, bl = P;
#pragma unroll
        for (int j = 0; j < 8; ++j) { const f32x2 t = *(const LAS f32x2*)(L + HG_T + (j * 128 + 2 * lane) * 4); if (j < w) P = P + t; if (j < 4) mm = mm + t; bl = bl + t; }
        unsigned kc0[4], kc1[4], vc0[4], vc1[4];
        float kprev0 = 0.f, kprev1 = 0.f;
#pragma unroll
        for (int r = 0; r < 8; ++r) {
            const f32x2 bb = P + cs[r];
            const float e1x = __expf(bb.x - mm.x), e1y = __expf(bb.y - mm.y), e2x = __expf(mm.x - bb.x), e2y = __expf(mm.y - bb.y);
            const float kx = -expm1f(lf[r].x) * e2x, ky = -expm1f(lf[r].y) * e2y;
            const int tau = 8 * w + r;
            *(LAS unsigned*)(L + HG_QP + tau * 272 + lane * 4) = cvtpk(bflo(qv[r]) * e1x, bfhi(qv[r]) * e1y);
            *(LAS unsigned*)(L + HG_KP + tau * 272 + lane * 4) = cvtpk(kx, ky);
            if (r & 1) { kc0[r >> 1] = cvtpk(kprev0, kx); kc1[r >> 1] = cvtpk(kprev1, ky);
                         vc0[r >> 1] = (vv[r - 1] & 0xffffu) | (vv[r] << 16); vc1[r >> 1] = (vv[r - 1] >> 16) | (vv[r] & 0xffff0000u); }
            else { kprev0 = kx; kprev1 = ky; }
        }
        *(LAS v4u*)(L + HG_KT + (2 * lane) * 144 + w * 16) = (v4u){kc0[0], kc0[1], kc0[2], kc0[3]};
        *(LAS v4u*)(L + HG_KT + (2 * lane + 1) * 144 + w * 16) = (v4u){kc1[0], kc1[1], kc1[2], kc1[3]};
        *(LAS v4u*)(L + HG_VT + (2 * lane) * 144 + w * 16) = (v4u){vc0[0], vc0[1], vc0[2], vc0[3]};
        *(LAS v4u*)(L + HG_VT + (2 * lane + 1) * 144 + w * 16) = (v4u){vc1[0], vc1[1], vc1[2], vc1[3]};
        if (w == 0) {
            *(LAS f32x2*)(L + HG_CV + (0 * 128 + 2 * lane) * 4) = (f32x2){__expf(mm.x), __expf(mm.y)};
            *(LAS f32x2*)(L + HG_CV + (1 * 128 + 2 * lane) * 4) = (f32x2){__expf(bl.x - mm.x), __expf(bl.y - mm.y)};
            *(LAS f32x2*)(L + HG_CV + (2 * 128 + 2 * lane) * 4) = (f32x2){__expf(bl.x), __expf(bl.y)};
        }
        if (s + 1 < 36) HG_LOAD(s + 1);
        LBAR();
        if (wanto) {
#pragma unroll
            for (int kt = 0; kt < 8; ++kt) { const f32x4 em = *(const LAS f32x4*)(L + HG_CV + (16 * kt + 4 * lq) * 4); const f32x4 sv = S[kt] * em;
                *(LAS u32x2*)(L + HG_ST + (16 * w + l15) * 272 + (16 * kt + 4 * lq) * 2) = (u32x2){cvtpk(sv.x, sv.y), cvtpk(sv.z, sv.w)}; }
            const int ti = w >> 1;
#pragma unroll
            for (int sx = 0; sx < 2; ++sx) { const int si = 2 * (w & 1) + sx; f32x4 a = (f32x4){0.f, 0.f, 0.f, 0.f};
                if (si <= ti) {
#pragma unroll
                    for (int ks = 0; ks < 4; ++ks) { const bf16x8 qa = *(const LAS bf16x8*)(L + HG_QP + (16 * ti + l15) * 272 + (32 * ks + 8 * lq) * 2);
                        const bf16x8 kb = *(const LAS bf16x8*)(L + HG_KP + (16 * si + l15) * 272 + (32 * ks + 8 * lq) * 2); a = MFMA16(qa, kb, a); }
                }
#pragma unroll
                for (int r = 0; r < 4; ++r) { const int tau = 16 * ti + 4 * lq + r, sig = 16 * si + l15; const float val = (si <= ti && sig <= tau) ? a[r] : 0.f;
                    *(LAS unsigned short*)(L + HG_AS + tau * 144 + sig * 2) = (unsigned short)(cvtpk(val, 0.f) & 0xffffu); }
            }
        }
        LBAR();
        bf16x8 bv[2];
#pragma unroll
        for (int ks = 0; ks < 2; ++ks) bv[ks] = *(const LAS bf16x8*)(L + HG_VT + (16 * w + l15) * 144 + (32 * ks + 8 * lq) * 2);
        if (wanto) {
            bf16x8 bs[4];
#pragma unroll
            for (int ks = 0; ks < 4; ++ks) bs[ks] = *(const LAS bf16x8*)(L + HG_ST + (16 * w + l15) * 272 + (32 * ks + 8 * lq) * 2);
#pragma unroll
            for (int ti = 0; ti < 4; ++ti) { f32x4 a = (f32x4){0.f, 0.f, 0.f, 0.f};
#pragma unroll
                for (int ks = 0; ks < 2; ++ks) { const bf16x8 aa = *(const LAS bf16x8*)(L + HG_AS + (16 * ti + l15) * 144 + (32 * ks + 8 * lq) * 2); a = MFMA16(aa, bv[ks], a); }
#pragma unroll
                for (int ks = 0; ks < 4; ++ks) { const bf16x8 qa = *(const LAS bf16x8*)(L + HG_QP + (16 * ti + l15) * 272 + (32 * ks + 8 * lq) * 2); a = MFMA16(qa, bs[ks], a); }
#pragma unroll
                for (int r = 0; r < 4; ++r) { const int tau = 16 * ti + 4 * lq + r; const int row = base + (dir ? 63 - tau : tau); const unsigned short ov = (unsigned short)(cvtpk(a[r], 0.f) & 0xffffu);
                    if (dir) Ob[(size_t)row * 512 + h * 128 + 16 * w + l15] = ov; else Of[(size_t)row * DM + h * 128 + 16 * w + l15] = ov; }
            }
        }
#pragma unroll
        for (int kt = 0; kt < 8; ++kt) { f32x4 u = (f32x4){0.f, 0.f, 0.f, 0.f};
#pragma unroll
            for (int ks = 0; ks < 2; ++ks) { const bf16x8 ka = *(const LAS bf16x8*)(L + HG_KT + (16 * kt + l15) * 144 + (32 * ks + 8 * lq) * 2); u = MFMA16(ka, bv[ks], u); }
            const f32x4 eu = *(const LAS f32x4*)(L + HG_CV + (128 + 16 * kt + 4 * lq) * 4), d = *(const LAS f32x4*)(L + HG_CV + (256 + 16 * kt + 4 * lq) * 4);
            S[kt] = d * S[kt] + eu * u; }
        LBAR();
    }
#undef HG_LOAD
#undef HG_BASE
}
constexpr int SG_WS = 0, SG_VH = 34816, SG_END = 34816 + 64 * 272;
__device__ __forceinline__ void sg_block(Frame& F, int layer, int sb) {
    const int g = sb & 3, j0 = sb >> 2, nCh = layer == 0 ? 144 : 128;
    LAS unsigned char* L = F.lds; const int lane = F.lane, w = F.wave, l15 = lane & 15, lq = lane >> 4, tid = F.tid;
    const float* Wg = IN_SG_W + ((size_t)layer * 4 + g) * 128 * 128;
#pragma unroll
    for (int i = 0; i < 8; ++i) { const int idx = tid * 4 + i * 2048, t = idx >> 7, s = idx & 127; const f32x4 v = *(const f32x4*)(Wg + idx);
        *(LAS u32x2*)(L + SG_WS + t * 272 + s * 2) = (u32x2){cvtpk(v.x, v.y), cvtpk(v.z, v.w)}; }
    LBAR();
    bf16x8 af[4];
#pragma unroll
    for (int ks = 0; ks < 4; ++ks) af[ks] = *(const LAS bf16x8*)(L + SG_WS + (16 * w + l15) * 272 + (32 * ks + 8 * lq) * 2);
    const bf16* PX = (const bf16*)(F.ws + WS_PX); bf16* MO = (bf16*)(F.ws + WS_XM);
    const float* lng = IN_SG_LN_G + layer * 256 + g * 64; const float* lnb = IN_SG_LN_B + layer * 256 + g * 64; const float* sgb = IN_SG_B + (layer * 4 + g) * 128;
    for (int ch = j0; ch < nCh; ch += 48) {
        const int rowbase = ch < 128 ? ch * 128 : MX + (ch - 128) * 128;
        { const int s = tid >> 2, p = tid & 3; const bf16* src = PX + (size_t)(rowbase + s) * PXW + PXC_VS + g * 64 + 16 * p;
          const v4u r0 = *(const v4u*)src, r1 = *(const v4u*)(src + 8); float x[16];
          x[0] = bflo(r0.x); x[1] = bfhi(r0.x); x[2] = bflo(r0.y); x[3] = bfhi(r0.y); x[4] = bflo(r0.z); x[5] = bfhi(r0.z); x[6] = bflo(r0.w); x[7] = bfhi(r0.w);
          x[8] = bflo(r1.x); x[9] = bfhi(r1.x); x[10] = bflo(r1.y); x[11] = bfhi(r1.y); x[12] = bflo(r1.z); x[13] = bfhi(r1.z); x[14] = bflo(r1.w); x[15] = bfhi(r1.w);
          float sm = 0.f;
#pragma unroll
          for (int i = 0; i < 16; ++i) sm += x[i];
          sm += __shfl_xor(sm, 1); sm += __shfl_xor(sm, 2); const float mean = sm * (1.f / 64.f); float q = 0.f;
#pragma unroll
          for (int i = 0; i < 16; ++i) { x[i] -= mean; q += x[i] * x[i]; }
          q += __shfl_xor(q, 1); q += __shfl_xor(q, 2); const float rstd = 1.f / sqrtf(q * (1.f / 64.f) + LN_EPS);
#pragma unroll
          for (int i = 0; i < 16; ++i) { const int c = 16 * p + i; const float y = x[i] * rstd * lng[c] + lnb[c];
              *(LAS unsigned short*)(L + SG_VH + c * 272 + s * 2) = (unsigned short)(cvtpk(y, 0.f) & 0xffffu); } }
        LBAR();
#pragma unroll
        for (int ct = 0; ct < 4; ++ct) { f32x4 a = (f32x4){0.f, 0.f, 0.f, 0.f};
#pragma unroll
            for (int ks = 0; ks < 4; ++ks) { const bf16x8 bfr = *(const LAS bf16x8*)(L + SG_VH + (16 * ct + l15) * 272 + (32 * ks + 8 * lq) * 2); a = MFMA16(af[ks], bfr, a); }
#pragma unroll
            for (int r = 0; r < 4; ++r) { const int t = 16 * w + 4 * lq + r, c = 16 * ct + l15; const size_t row = (size_t)(rowbase + t);
                const float uu = bf1(PX[row * PXW + PXC_U + g * 64 + c]); const float val = uu * (a[r] + sgb[t]);
                MO[row * DM + 768 + g * 64 + c] = (unsigned short)(cvtpk(val, 0.f) & 0xffffu); } }
        LBAR();
    }
}
__device__ __forceinline__ void sc_items(Frame& F, int layer, int first, int stride) {
    const bf16* PX = (const bf16*)(F.ws + WS_PX); bf16* MO = (bf16*)(F.ws + WS_XM); const float* cw = IN_SC_CONV_W + layer * 3 * 256;
    const int nrows = layer == 0 ? MT : MX;
    for (int idx = first; idx < nrows * 32; idx += stride) {
        const int row = idx >> 5, cg = idx & 31; const int t = row < MX ? (row & (SEQ - 1)) : ((row - MX) & (CTXL - 1)), T = row < MX ? SEQ : CTXL;
        const bf16* p = PX + (size_t)row * PXW + 8 * cg;
        const v4u gb = *(const v4u*)(p + PXC_GB), gc1 = *(const v4u*)(p + PXC_GC), h1 = *(const v4u*)(p + PXC_HS);
        v4u gc0 = (v4u){0u, 0u, 0u, 0u}, h0 = gc0, gc2 = gc0, h2 = gc0;
        if (t > 0) { gc0 = *(const v4u*)(p - PXW + PXC_GC); h0 = *(const v4u*)(p - PXW + PXC_HS); }
        if (t < T - 1) { gc2 = *(const v4u*)(p + PXW + PXC_GC); h2 = *(const v4u*)(p + PXW + PXC_HS); }
        const f32x4 w0a = *(const f32x4*)(cw + 8 * cg), w0b = *(const f32x4*)(cw + 8 * cg + 4), w1a = *(const f32x4*)(cw + 256 + 8 * cg), w1b = *(const f32x4*)(cw + 256 + 8 * cg + 4),
                    w2a = *(const f32x4*)(cw + 512 + 8 * cg), w2b = *(const f32x4*)(cw + 512 + 8 * cg + 4);
        float o[8];
#define SC_E(i, W0, W1, W2, GB, C0, H0, C1, H1, C2, H2, LO) o[i] = (LO ? bflo(GB) : bfhi(GB)) * ((W0) * (LO ? bflo(C0) * bflo(H0) : bfhi(C0) * bfhi(H0)) + (W1) * (LO ? bflo(C1) * bflo(H1) : bfhi(C1) * bfhi(H1)) + (W2) * (LO ? bflo(C2) * bflo(H2) : bfhi(C2) * bfhi(H2)))
        SC_E(0, w0a.x, w1a.x, w2a.x, gb.x, gc0.x, h0.x, gc1.x, h1.x, gc2.x, h2.x, 1); SC_E(1, w0a.y, w1a.y, w2a.y, gb.x, gc0.x, h0.x, gc1.x, h1.x, gc2.x, h2.x, 0);
        SC_E(2, w0a.z, w1a.z, w2a.z, gb.y, gc0.y, h0.y, gc1.y, h1.y, gc2.y, h2.y, 1); SC_E(3, w0a.w, w1a.w, w2a.w, gb.y, gc0.y, h0.y, gc1.y, h1.y, gc2.y, h2.y, 0);
        SC_E(4, w0b.x, w1b.x, w2b.x, gb.z, gc0.z, h0.z, gc1.z, h1.z, gc2.z, h2.z, 1); SC_E(5, w0b.y, w1b.y, w2b.y, gb.z, gc0.z, h0.z, gc1.z, h1.z, gc2.z, h2.z, 0);
        SC_E(6, w0b.z, w1b.z, w2b.z, gb.w, gc0.w, h0.w, gc1.w, h1.w, gc2.w, h2.w, 1); SC_E(7, w0b.w, w1b.w, w2b.w, gb.w, gc0.w, h0.w, gc1.w, h1.w, gc2.w, h2.w, 0);
#undef SC_E
        *(v4u*)(MO + (size_t)row * DM + 512 + 8 * cg) = (v4u){cvtpk(o[0], o[1]), cvtpk(o[2], o[3]), cvtpk(o[4], o[5]), cvtpk(o[6], o[7])};
    }
}
__device__ __forceinline__ void phase_mixb(Frame& F, int layer) {
    const int gw = F.vcu * NWAVES + F.wave, NGW = F.G * NWAVES; const int nrows = layer == 0 ? MT : MX;
    bf16* MO = (bf16*)(F.ws + WS_XM); const bf16* OB = (const bf16*)(F.ws + WS_OB); const bf16* PX = (const bf16*)(F.ws + WS_PX);
    const float* ng = IN_HG_NORM_G + layer * 128 + ((8 * F.lane) & 127);
    const f32x4 n0 = *(const f32x4*)ng, n1 = *(const f32x4*)(ng + 4);
    for (int row = gw; row < nrows; row += NGW) {
        const v4u a = *(const v4u*)(MO + (size_t)row * DM + 8 * F.lane), bq = *(const v4u*)(OB + (size_t)row * 512 + 8 * F.lane), gt = *(const v4u*)(PX + (size_t)row * PXW + PXC_G + 8 * F.lane);
        float o[8]; o[0] = bflo(a.x) + bflo(bq.x); o[1] = bfhi(a.x) + bfhi(bq.x); o[2] = bflo(a.y) + bflo(bq.y); o[3] = bfhi(a.y) + bfhi(bq.y);
        o[4] = bflo(a.z) + bflo(bq.z); o[5] = bfhi(a.z) + bfhi(bq.z); o[6] = bflo(a.w) + bflo(bq.w); o[7] = bfhi(a.w) + bfhi(bq.w);
        float ss = 0.f;
#pragma unroll
        for (int i = 0; i < 8; ++i) ss += o[i] * o[i];
        ss += __shfl_xor(ss, 1); ss += __shfl_xor(ss, 2); ss += __shfl_xor(ss, 4); ss += __shfl_xor(ss, 8);
        const float rs = 1.f / sqrtf(ss * (1.f / 128.f) + LN_EPS);
        const float g0 = bflo(gt.x), g1 = bfhi(gt.x), g2 = bflo(gt.y), g3 = bfhi(gt.y), g4 = bflo(gt.z), g5 = bfhi(gt.z), g6 = bflo(gt.w), g7 = bfhi(gt.w);
        *(v4u*)(MO + (size_t)row * DM + 8 * F.lane) = (v4u){cvtpk(o[0] * rs * n0.x * g0, o[1] * rs * n0.y * g1), cvtpk(o[2] * rs * n0.z * g2, o[3] * rs * n0.w * g3),
                                                            cvtpk(o[4] * rs * n1.x * g4, o[5] * rs * n1.y * g5), cvtpk(o[6] * rs * n1.z * g6, o[7] * rs * n1.w * g7)};
    }
}
__device__ __forceinline__ float gelu_erf(float v) { return 0.5f * v * (1.f + erff(v * 0.70710678118654752f)); }
__device__ __forceinline__ void phase_conv(Frame& F, int layer, int nT, int nXimg) {
    const bf16* A = (const bf16*)(F.ws + WS_PX); bf16* Gb = (bf16*)(F.ws + WS_PX + (size_t)nT * 256 * DFF * 2);
    const int nXrows = nXimg * SEQ, nCrows = nT * 256 - nXrows;
    const int nItems = (nXrows + nCrows) / 16;
    const int cg = F.tid; if (cg >= DFF / 8) return;
    const float* cw = IN_FFN_CONV_W + (size_t)layer * 9 * DFF + 8 * cg; const float* cb = IN_FFN_CONV_B + (size_t)layer * DFF + 8 * cg;
    for (int it = F.vcu; it < nItems; it += F.G) {
        const int r0 = it * 16;
        int Hh, Ww, gi, gj0, imgbase;
        if (r0 < nXrows) { Hh = 32; Ww = 64; imgbase = r0 & ~(SEQ - 1); gi = (r0 - imgbase) >> 6; gj0 = (r0 - imgbase) & 63; }
        else { Hh = 1; Ww = 256; imgbase = nXrows + ((r0 - nXrows) & ~(CTXL - 1)); gi = 0; gj0 = (r0 - imgbase); }
        for (int jj = 0; jj < 16; ++jj) {
            const int gj = gj0 + jj; float acc[8];
            { const f32x4 b0 = *(const f32x4*)cb, b1 = *(const f32x4*)(cb + 4); acc[0] = b0.x; acc[1] = b0.y; acc[2] = b0.z; acc[3] = b0.w; acc[4] = b1.x; acc[5] = b1.y; acc[6] = b1.z; acc[7] = b1.w; }
#pragma unroll
            for (int di = 0; di < 3; ++di)
#pragma unroll
                for (int dj = 0; dj < 3; ++dj) { const int ii = gi + di - 1, jc = gj + dj - 1;
                    if (ii >= 0 && ii < Hh && jc >= 0 && jc < Ww) { const v4u av = *(const v4u*)(A + (size_t)(imgbase + ii * Ww + jc) * DFF + 8 * cg);
                        const f32x4 w0 = *(const f32x4*)(cw + (di * 3 + dj) * DFF), w1 = *(const f32x4*)(cw + (di * 3 + dj) * DFF + 4);
                        acc[0] += bflo(av.x) * w0.x; acc[1] += bfhi(av.x) * w0.y; acc[2] += bflo(av.y) * w0.z; acc[3] += bfhi(av.y) * w0.w;
                        acc[4] += bflo(av.z) * w1.x; acc[5] += bfhi(av.z) * w1.y; acc[6] += bflo(av.w) * w1.z; acc[7] += bfhi(av.w) * w1.w; } }
            bf16* gp = Gb + (size_t)(imgbase + gi * Ww + gj) * DFF + 8 * cg; const v4u gv = *(const v4u*)gp;
            *(v4u*)gp = (v4u){cvtpk(gelu_erf(acc[0]) * bflo(gv.x), gelu_erf(acc[1]) * bfhi(gv.x)), cvtpk(gelu_erf(acc[2]) * bflo(gv.y), gelu_erf(acc[3]) * bfhi(gv.y)),
                              cvtpk(gelu_erf(acc[4]) * bflo(gv.z), gelu_erf(acc[5]) * bfhi(gv.z)), cvtpk(gelu_erf(acc[6]) * bflo(gv.w), gelu_erf(acc[7]) * bfhi(gv.w))};
        }
    }
}
struct Args { const float* in[23]; float* out; unsigned char* ws; int ph_lo, ph_hi; };
#ifndef PH_LIMIT
#define PH_LIMIT 1000
#endif
__global__ void __launch_bounds__(NWAVES * 64, 2) fwd_megakernel(Args args) {
    extern __shared__ __attribute__((aligned(16))) unsigned char lds[];
    Frame F;
    F.lds = (LAS unsigned char*)lds;
    F.MISC = (volatile LAS unsigned*)(F.lds + MISC_OFF);
    F.tid = threadIdx.x; F.lane = F.tid & 63; F.wave = __builtin_amdgcn_readfirstlane(F.tid >> 6);
    F.G = gridDim.x; { const int bx = blockIdx.x; F.vcu = (F.G % 8 == 0) ? (bx % 8) * (F.G / 8) + bx / 8 : bx; }
    F.ws = args.ws; F.ctl = (gu32*)(args.ws + WS_CTL); F.out = args.out;
    for (int u = F.tid; u < (LDS_BYTES - LDSCTL_OFF) / 4; u += NWAVES * 64) ((LAS unsigned*)(F.lds + LDSCTL_OFF))[u] = 0u;
    __syncthreads();
    XcdBarrier bar = xcd_barrier_post((unsigned*)(F.ctl + CW_BAR), F.MISC + 8);
    int phase = 0;
#define PHASE_BEGIN() do { int t_ = threadIdx.x; asm volatile("" : "+v"(t_)); F.tid = t_; F.lane = t_ & 63; unsigned long long w_ = (unsigned long long)args.ws; asm volatile("" : "+s"(w_)); F.ws = (unsigned char*)w_; \
        unsigned long long o_ = (unsigned long long)args.out; asm volatile("" : "+s"(o_)); F.out = (float*)o_; } while (0)
#ifndef DUMP_PITCH
#define DUMP_PITCH 1
#define DUMP_C0 0
#define DUMP_C1 1
#endif
#ifndef DUMP_LO
#define DUMP_LO 0
#define DUMP_HI 0
#endif
#define GRID_BAR() do { xcd_barrier(bar); ++phase; if (phase >= PH_LIMIT) { if (DUMP_HI > DUMP_LO) { const unsigned* src_ = (const unsigned*)(args.ws + (size_t)DUMP_LO * MiB); const size_t nw_ = (size_t)(DUMP_HI - DUMP_LO) * MiB / 4; \
        for (size_t i_ = (size_t)blockIdx.x * 512 + threadIdx.x; i_ < (size_t)MX * DM; i_ += (size_t)gridDim.x * 512) { unsigned a_ = 0u; for (size_t j_ = i_; j_ < nw_; j_ += (size_t)MX * DM) { const unsigned c_ = (unsigned)(j_ % DUMP_PITCH); if (c_ >= DUMP_C0 && c_ < DUMP_C1) a_ ^= src_[j_]; } args.out[i_] = (float)(a_ & 0xffffffu); } } return; } PHASE_BEGIN(); } while (0)
#define XM ((bf16*)(F.ws + WS_XM))
#define PXb ((bf16*)(F.ws + WS_PX))

#ifndef NO_P0
    convert_weights(F, 0, 3);
    WGBAR();
    p0_mod(F);
#endif
    GRID_BAR();
#ifndef NO_R
    phase_r1(F);
#endif
    GRID_BAR();
#pragma unroll 1
    for (int layer = 0; layer < 2; ++layer) {
#ifndef NO_G1
        { pg8::Gemm g{XM, (const bf16*)(F.ws + WS_WIN), MT, INC, DM}; pg8::OrderG1 S; S.init(F.G, (int)blockIdx.x, layer == 0 ? 15 : 6);
          pg8::EpiIn E{PXb, (float*)(F.ws + WS_LF), (const float*)(F.ws + WS_LBV) + layer * 1024};
          pg8::gemm_phase<pg8::EpiIn, pg8::OrderG1, true, true>(F.lds + RING_OFF, g, S, E); }
#endif
        GRID_BAR();
#ifndef NO_HG
        if (F.vcu < 64) hgrn_scan(F, layer, F.vcu);
#endif
#ifndef NO_SG
        if (F.vcu >= 64) { sg_block(F, layer, F.vcu - 64); sc_items(F, layer, (F.vcu - 64) * 512 + F.tid, (F.G - 64) * 512); }
#endif
        GRID_BAR();
#ifndef NO_R
        phase_mixb(F, layer);
#endif
        GRID_BAR();
#ifndef NO_G2
        { const int M2 = layer == 0 ? MT : MX; pg8::Gemm g{XM, (const bf16*)(F.ws + WS_WOUT), M2, DM, DM}; pg8::StaticOrder S; S.init(M2, DM, F.G, (int)blockIdx.x);
          pg8::EpiF32 E{(float*)(F.ws + WS_LF), DM, nullptr};
          pg8::gemm_phase<pg8::EpiF32, pg8::StaticOrder, true, true>(F.lds + RING_OFF, g, S, E); }
#endif
        GRID_BAR();
#ifndef NO_R
        phase_r2(F, layer);
        WGBAR();
#endif
#ifndef NO_P0
        if (layer == 0) convert_weights(F, 1, 1); else convert_weights(F, 1, 2);
#endif
        GRID_BAR();
        const int njobs = layer == 0 ? 2 : 1;
#pragma unroll 1
        for (int job = 0; job < njobs; ++job) {
            int nT, split, off1, off2, nXimg;
            if (layer == 0) { if (job == 0) { nT = 40; split = 32; off1 = 0; off2 = 32; nXimg = 4; } else { nT = 32; split = 32; off1 = 32; off2 = 32; nXimg = 4; } }
            else { nT = 64; split = 64; off1 = 0; off2 = 0; nXimg = 8; }
#ifndef NO_G3
            { pg8::Gemm g{XM, (const bf16*)(F.ws + WS_WUP), nT * 256, 2 * DFF, DM}; pg8::OrderJob S; S.init(nT, 22, F.G, (int)blockIdx.x, split, off1, off2);
              pg8::EpiBf16<0> E{PXb, DFF, nullptr, DFF, (size_t)nT * 256 * DFF, 1.f};
              pg8::gemm_phase<pg8::EpiBf16<0>, pg8::OrderJob, true, true>(F.lds + RING_OFF, g, S, E); }
#endif
            GRID_BAR();
#ifndef NO_CONV
            phase_conv(F, layer, nT, nXimg);
#endif
            GRID_BAR();
#ifndef NO_G4
            { pg8::Gemm g{PXb + (size_t)nT * 256 * DFF, (const bf16*)(F.ws + WS_WDN), nT * 256, DM, DFF}; pg8::StaticOrder S; S.init(nT * 256, DM, F.G, (int)blockIdx.x);
              pg8::EpiF32 E{(float*)(F.ws + WS_PX), DM, nullptr};
              pg8::gemm_phase<pg8::EpiF32, pg8::StaticOrder, true, true>(F.lds + RING_OFF, g, S, E); }
#endif
            GRID_BAR();
#ifndef NO_R
            phase_r3(F, layer, nT, split, off1, off2);
#endif
            if (!(layer == 1)) GRID_BAR();
        }
    }
}

extern "C" void kernel_launch(void* const* d_in, const int* in_sizes, int n_in, void* d_out, int out_size, void* d_ws, size_t ws_size, hipStream_t stream) {
    static int grid = 0;
    if (grid == 0) {
        if (n_in != 23 || in_sizes[0] != MX * DM || out_size != MX * DM || ws_size < WS_END) { fprintf(stderr, "kernel_launch: unexpected shapes (n_in %d, in0 %d, out %d, ws %zu); nothing launched\n", n_in, n_in > 0 ? in_sizes[0] : -1, out_size, ws_size); grid = -1; return; }
        int dev = 0, cus = 0, per_cu = 0;
        if (hipGetDevice(&dev) != hipSuccess || hipDeviceGetAttribute(&cus, hipDeviceAttributeMultiprocessorCount, dev) != hipSuccess) { grid = -1; return; }
        if (hipFuncSetAttribute((const void*)fwd_megakernel, hipFuncAttributeMaxDynamicSharedMemorySize, LDS_BYTES) != hipSuccess) { fprintf(stderr, "kernel_launch: hipFuncSetAttribute failed\n"); grid = -1; return; }
        if (hipOccupancyMaxActiveBlocksPerMultiprocessor(&per_cu, (const void*)fwd_megakernel, NWAVES * 64, LDS_BYTES) != hipSuccess || per_cu < 1) { fprintf(stderr, "kernel_launch: occupancy query says %d workgroups per CU; nothing launched\n", per_cu); (void)hipGetLastError(); grid = -1; return; }
        grid = cus;
    }
    if (grid < 0) return;
    if (hipMemsetAsync((char*)d_ws + WS_CTL, 0, CTL_ZERO_BYTES, stream) != hipSuccess) return;
    Args a{};
    for (int i = 0; i < 23; ++i) a.in[i] = (const float*)d_in[i];
    a.out = (float*)d_out; a.ws = (unsigned char*)d_ws; a.ph_lo = 0; a.ph_hi = 0;
    hipLaunchKernelGGL(fwd_megakernel, dim3(grid), dim3(NWAVES * 64), LDS_BYTES, stream, a);
}
```

```cpp
#include <hip/hip_runtime.h>
#include <cstdio>
#include <cstdint>
namespace pg8 {
#define PG8_LAS __attribute__((address_space(3)))
typedef unsigned short bf16_t;
typedef short bf16x8 __attribute__((ext_vector_type(8)));
typedef float f32x4 __attribute__((ext_vector_type(4)));
typedef unsigned u32x4 __attribute__((ext_vector_type(4)));
constexpr int BM = 256, BK = 64, HALF = 128, HTB = HALF * BK * 2  , STAGE_BYTES = 8 * HTB, NXCD = 8, WGM = 8;

__host__ __device__ __forceinline__ int lds_byte(int r, int c) { const int st = (r >> 4) * 2 + (c >> 5), rr = r & 15, cc = c & 31, ob = rr * 64 + cc * 2; return st * 1024 + (ob ^ (((ob >> 9) & 1) << 5)); }
__host__ __device__ __forceinline__ void stage_rc(int b, int& R, int& C) { const int st = b / 1024, sb = b % 1024, swz = sb ^ (((sb >> 9) & 1) << 5); R = (st >> 1) * 16 + swz / 64; C = (st & 1) * 32 + (swz % 64) / 2; }
__host__ __device__ __forceinline__ int perm32(int rho) { const int n = rho >> 4, i = rho & 15; return 8 * (i >> 2) + 4 * n + (i & 3); }

struct Unit { int pm, pn; };
struct Gemm { const bf16_t* A; const bf16_t* Bt; int M, N, K; };

struct StaticOrder {
    int nM, nN, nwg, G, c;
    __host__ __device__ void init(int M, int N, int G_, int c_) { nM = M / BM; nN = N / BM; nwg = nM * nN; G = G_; c = c_; }
    __host__ __device__ bool next(int i, Unit& u) const {
        const long L = (long)i * G + c; if (L >= nwg) return false;
        int wgid = (int)L; { const int q = nwg / NXCD, r = nwg % NXCD, xcd = wgid % NXCD, off = wgid / NXCD; wgid = (xcd < r ? xcd * (q + 1) : r * (q + 1) + (xcd - r) * q) + off; }
        const int nig = WGM * nN, gid = wgid / nig, fm = gid * WGM, gsz = (nM - fm) < WGM ? (nM - fm) : WGM;
        u.pm = fm + ((wgid % nig) % gsz); u.pn = (wgid % nig) / gsz; return true;
    }
    __device__ __forceinline__ void a_ready(const Unit&) const {}
    __device__ __forceinline__ int arow(const Unit& u) const { return u.pm; }
    __device__ __forceinline__ void done(const Unit&) const {}
};

typedef __bf16 bf16x2v_ __attribute__((ext_vector_type(2)));
__device__ __forceinline__ unsigned cvt_pk_bf16(float lo, float hi) { typedef float f2_ __attribute__((ext_vector_type(2))); const f2_ v = {lo, hi}; return __builtin_bit_cast(unsigned, __builtin_convertvector(v, bf16x2v_)); }
typedef float f32x2 __attribute__((ext_vector_type(2)));
__device__ __forceinline__ f32x2 gelu_pk(f32x2 v) {
    const f32x2 av = __builtin_elementwise_abs(v), d = av * 0.2316418882f + 1.0f;
    f32x2 t; t.x = __builtin_amdgcn_rcpf(d.x); t.y = __builtin_amdgcn_rcpf(d.y);
    f32x2 q = t * 0.5307027145f + (-0.7265760135f); q = q * t + 0.7107068705f; q = q * t + (-0.142248368f); q = q * t + 0.127414796f; q = q * t;
    const f32x2 s = (v * v) * (-0.72134752044f);
    f32x2 e; e.x = __builtin_amdgcn_exp2f(s.x); e.y = __builtin_amdgcn_exp2f(s.y);
    const f32x2 m = v * (q * e), r = v - m;
    f32x2 o; o.x = v.x < 0.f ? m.x : r.x; o.y = v.y < 0.f ? m.y : r.y; return o;
}

template <int ACT  > struct EpiBf16 {
    static constexpr bool PERM = true, AFTER_DRAIN = false; static_assert(ACT == 0 || ACT == 1, "EpiBf16: ACT is 0 (none) or 1 (gelu_pk)");
    bf16_t* O; int ldc; const float* bias; int split_cols; size_t split_stride; float scale0;
    __device__ __forceinline__ void operator()(const f32x4 (&acc)[2][2][4][2], const Unit& u, int wr, int wc, int fr, int fq) const {
        const int row0 = u.pm * BM + wr * 64 + fr; int colt = u.pn * BM; bf16_t* base = O;
        float sc = 1.f; if (split_cols) { const int t = colt / split_cols; base += (size_t)t * split_stride; colt -= t * split_cols; if (t == 0) sc = scale0; }
        const int col0 = colt + wc * 32 + 8 * fq, bcol0 = u.pn * BM + wc * 32 + 8 * fq;
        f32x4 bv[2][2];
#pragma unroll
        for (int bj = 0; bj < 2; ++bj)
#pragma unroll
            for (int n = 0; n < 2; ++n) bv[bj][n] = bias ? *(const f32x4*)(bias + bcol0 + bj * HALF + 4 * n) : (f32x4){0.f, 0.f, 0.f, 0.f};
#pragma unroll
        for (int ai = 0; ai < 2; ++ai)
#pragma unroll
            for (int m = 0; m < 4; ++m) { bf16_t* rowp = base + (size_t)(row0 + ai * HALF + m * 16) * ldc + col0;
#pragma unroll
                for (int bj = 0; bj < 2; ++bj) { f32x4 v0 = acc[ai][bj][m][0] + bv[bj][0], v1 = acc[ai][bj][m][1] + bv[bj][1];
                    if (ACT == 1) { f32x2 a = gelu_pk((f32x2){v0[0], v0[1]}), b = gelu_pk((f32x2){v0[2], v0[3]}), c = gelu_pk((f32x2){v1[0], v1[1]}), d = gelu_pk((f32x2){v1[2], v1[3]});
                        v0 = (f32x4){a.x, a.y, b.x, b.y}; v1 = (f32x4){c.x, c.y, d.x, d.y}; }
                    v0 = v0 * sc; v1 = v1 * sc; u32x4 w; w.x = cvt_pk_bf16(v0[0], v0[1]); w.y = cvt_pk_bf16(v0[2], v0[3]); w.z = cvt_pk_bf16(v1[0], v1[1]); w.w = cvt_pk_bf16(v1[2], v1[3]);
                    *(u32x4*)(rowp + bj * HALF) = w; } }
    }
};
struct EpiF32 {
    static constexpr bool PERM = false, AFTER_DRAIN = false;
    float* C; int ldc; const float* bias;
    __device__ __forceinline__ void operator()(const f32x4 (&acc)[2][2][4][2], const Unit& u, int wr, int wc, int fr, int fq) const {
        const int row0 = u.pm * BM + wr * 64 + fr, col0 = u.pn * BM + wc * 32 + 4 * fq;
        f32x4 bv[2][2];
#pragma unroll
        for (int bj = 0; bj < 2; ++bj)
#pragma unroll
            for (int n = 0; n < 2; ++n) bv[bj][n] = bias ? *(const f32x4*)(bias + col0 + bj * HALF + n * 16) : (f32x4){0.f, 0.f, 0.f, 0.f};
#pragma unroll
        for (int ai = 0; ai < 2; ++ai)
#pragma unroll
            for (int m = 0; m < 4; ++m) { float* rowp = C + (size_t)(row0 + ai * HALF + m * 16) * ldc + col0;
#pragma unroll
                for (int bj = 0; bj < 2; ++bj)
#pragma unroll
                    for (int n = 0; n < 2; ++n) *(f32x4*)(rowp + bj * HALF + n * 16) = acc[ai][bj][m][n] + bv[bj][n]; }
    }
};
struct OrderJob {
    StaticOrder so; int split, off1, off2;
    __device__ void init(int nT, int nN, int G_, int c_, int split_, int off1_, int off2_) { so.init(nT * BM, nN * BM, G_, c_); split = split_; off1 = off1_; off2 = off2_; }
    __device__ bool next(int i, Unit& u) const { return so.next(i, u); }
    __device__ __forceinline__ void a_ready(const Unit&) const {}
    __device__ __forceinline__ void done(const Unit&) const {}
    __device__ __forceinline__ int arow(const Unit& u) const { return u.pm + (u.pm < split ? off1 : off2); }
};
struct OrderG1 {
    StaticOrder so; int nNc, G, c;
    __device__ void init(int G_, int c_, int nNc_) { so.init(64 * BM, 15 * BM, G_, c_); nNc = nNc_; G = G_; c = c_; }
    __device__ bool next(int i, Unit& u) const {
        const long L = (long)i * G + c;
        if (L < 960) return so.next(i, u);
        const int j = (int)L - 960; if (j >= 8 * nNc) return false;
        u.pm = 64 + (j & 7); u.pn = j >> 3; return true;
    }
    __device__ __forceinline__ void a_ready(const Unit&) const {}
    __device__ __forceinline__ void done(const Unit&) const {}
    __device__ __forceinline__ int arow(const Unit& u) const { return u.pm; }
};
struct EpiIn {
    static constexpr bool PERM = true, AFTER_DRAIN = false;
    bf16_t* PX; float* LF; const float* lbv;
    __device__ __forceinline__ void operator()(const f32x4 (&acc)[2][2][4][2], const Unit& u, int wr, int wc, int fr, int fq) const {
        const int row0 = u.pm * BM + wr * 64 + fr; const int pn = u.pn;
        const int cbase = pn * BM + wc * 32 + 8 * fq;
        if (pn >= 2 && pn < 6) {
            f32x4 lb0[2], lb1[2];
#pragma unroll
            for (int bj = 0; bj < 2; ++bj) { lb0[bj] = *(const f32x4*)(lbv + cbase - 512 + bj * HALF); lb1[bj] = *(const f32x4*)(lbv + cbase - 512 + bj * HALF + 4); }
#pragma unroll
            for (int ai = 0; ai < 2; ++ai)
#pragma unroll
                for (int m = 0; m < 4; ++m) { float* rowp = LF + (size_t)(row0 + ai * HALF + m * 16) * 1024 + (cbase - 512);
#pragma unroll
                    for (int bj = 0; bj < 2; ++bj) { f32x4 v0 = acc[ai][bj][m][0], v1 = acc[ai][bj][m][1], o0, o1;
#pragma unroll
                        for (int j = 0; j < 4; ++j) {
                            const float s0 = 1.f / (1.f + __expf(-v0[j])), s1 = 1.f / (1.f + __expf(-v1[j]));
                            o0[j] = __logf(fmaxf(lb0[bj][j] + (1.f - lb0[bj][j]) * s0, 1e-30f));
                            o1[j] = __logf(fmaxf(lb1[bj][j] + (1.f - lb1[bj][j]) * s1, 1e-30f)); }
                        *(f32x4*)(rowp + bj * HALF) = o0; *(f32x4*)(rowp + bj * HALF + 4) = o1; } }
        } else {
            const int pcol = (pn < 2) ? cbase : cbase - 1024;
            const int act = (pn == 6 || pn == 7) ? 1 : ((pn == 8 || pn == 9) ? 2 : 0);
            const float sc = (act == 1) ? 0.08838834764831845f : 1.f;
#pragma unroll
            for (int ai = 0; ai < 2; ++ai)
#pragma unroll
                for (int m = 0; m < 4; ++m) { bf16_t* rowp = PX + (size_t)(row0 + ai * HALF + m * 16) * 2816 + pcol;
#pragma unroll
                    for (int bj = 0; bj < 2; ++bj) { f32x4 v0 = acc[ai][bj][m][0], v1 = acc[ai][bj][m][1];
                        if (act) {
#pragma unroll
                            for (int j = 0; j < 4; ++j) { v0[j] = v0[j] * sc / (1.f + __expf(-v0[j])); v1[j] = v1[j] * sc / (1.f + __expf(-v1[j])); } }
                        u32x4 w; w.x = cvt_pk_bf16(v0[0], v0[1]); w.y = cvt_pk_bf16(v0[2], v0[3]); w.z = cvt_pk_bf16(v1[0], v1[1]); w.w = cvt_pk_bf16(v1[2], v1[3]);
                        *(u32x4*)(rowp + bj * HALF) = w; } }
        }
    }
};
template <class Epi, class Sched, bool ALIGN_EPI = false, bool SP2 = false>
__device__ __forceinline__ void gemm_phase(PG8_LAS unsigned char* lds, const Gemm g, const Sched& S, const Epi& E, int tid_in) {
    int tid_ = tid_in; asm volatile("" : "+v"(tid_));
    const int tid = tid_, wid = __builtin_amdgcn_readfirstlane(tid >> 6), lane = tid & 63, wr = wid >> 2, wc = wid & 3, fr = lane & 15, fq = lane >> 4;
    const int K = g.K, nt = K / BK;
    unsigned voffA[2], voffB[2];
#pragma unroll
    for (int i = 0; i < 2; ++i) { int R, C; stage_rc(tid * 16 + i * 8192, R, C); const int Rb = Epi::PERM ? ((R & ~31) + perm32(R & 31)) : R;
        voffA[i] = (unsigned)(R * K + C) * 2u; voffB[i] = (unsigned)(Rb * K + C) * 2u; }
    const size_t kstep = (size_t)(BK * 2);
    const size_t hstep = (size_t)HALF * K * 2;
    const size_t tstep = 2 * hstep;
    const unsigned ldsw = (unsigned)wid * 1024u;
    const int aoff = lds_byte(wr * 64 + fr, fq * 8), boff = lds_byte(wc * 32 + fr, fq * 8);
#define PG8_SA(b, h) (((b) * 2 + (h)) * HTB)
#define PG8_SB(b, h) ((4 + (b) * 2 + (h)) * HTB)
#define PG8_STAGE(bufoff, gbase, voff) do { _Pragma("unroll") for (int _i = 0; _i < 2; ++_i) \
        __builtin_amdgcn_global_load_lds((const unsigned*)((const char*)(gbase) + (voff)[_i]), (PG8_LAS unsigned*)(lds + (bufoff) + ldsw + _i * 8192), 16, 0, 0); } while (0)
#define PG8_LDA(dst, b, h) do { _Pragma("unroll") for (int m = 0; m < 4; ++m) _Pragma("unroll") for (int k = 0; k < 2; ++k) dst[m][k] = *(const PG8_LAS bf16x8*)(lds + PG8_SA(b, h) + aoff + m * 2048 + k * 1024); } while (0)
#define PG8_LDB(dst, b, h) do { _Pragma("unroll") for (int n = 0; n < 2; ++n) _Pragma("unroll") for (int k = 0; k < 2; ++k) dst[n][k] = *(const PG8_LAS bf16x8*)(lds + PG8_SB(b, h) + boff + n * 2048 + k * 1024); } while (0)
#define PG8_MMA(ai, bj, At, Bt) do { __builtin_amdgcn_s_setprio(1); _Pragma("unroll") for (int m = 0; m < 4; ++m) _Pragma("unroll") for (int n = 0; n < 2; ++n) _Pragma("unroll") for (int k = 0; k < 2; ++k) \
        acc[ai][bj][m][n] = __builtin_amdgcn_mfma_f32_16x16x32_bf16(Bt[n][k], At[m][k], acc[ai][bj][m][n], 0, 0, 0); __builtin_amdgcn_s_setprio(0); } while (0)
#define PG8_WAIT_V(n) asm volatile("s_waitcnt vmcnt(" #n ")" ::: "memory")
#define PG8_WAIT_L(n) asm volatile("s_waitcnt lgkmcnt(" #n ")" ::: "memory")
#define PG8_BAR __builtin_amdgcn_s_barrier()
#define PG8_SCHED __builtin_amdgcn_sched_barrier(0)
    Unit cur, nxt; int ui = 0;
    if (!S.next(0, cur)) return;
    f32x4 acc[2][2][4][2];
#pragma unroll
    for (int a = 0; a < 2; ++a)
#pragma unroll
        for (int b = 0; b < 2; ++b)
#pragma unroll
            for (int m = 0; m < 4; ++m)
#pragma unroll
                for (int n = 0; n < 2; ++n) acc[a][b][m][n] = (f32x4){0.f, 0.f, 0.f, 0.f};
    bf16x8 At[4][2], B0[2][2], B1[2][2];
    const char* cA = (const char*)g.A + (size_t)S.arow(cur) * tstep; const char* cB = (const char*)g.Bt + (size_t)cur.pn * tstep;
    S.a_ready(cur);
    if constexpr (SP2) {
        PG8_STAGE(PG8_SB(0, 0), cB, voffB); PG8_STAGE(PG8_SB(0, 1), cB + hstep, voffB); PG8_STAGE(PG8_SA(0, 0), cA, voffA); PG8_STAGE(PG8_SA(0, 1), cA + hstep, voffA);
        if (wr == 1) PG8_BAR;
        PG8_WAIT_V(2); PG8_BAR;
        PG8_STAGE(PG8_SB(1, 0), cB + kstep, voffB); PG8_STAGE(PG8_SA(1, 0), cA + kstep, voffA); PG8_STAGE(PG8_SB(1, 1), cB + hstep + kstep, voffB);
        PG8_WAIT_V(6); PG8_BAR;
    } else {
        PG8_STAGE(PG8_SB(0, 0), cB, voffB); PG8_STAGE(PG8_SA(0, 0), cA, voffA); PG8_STAGE(PG8_SB(0, 1), cB + hstep, voffB); PG8_STAGE(PG8_SA(0, 1), cA + hstep, voffA);
        if (wr == 1) PG8_BAR;
        PG8_WAIT_V(4); PG8_BAR;
        PG8_STAGE(PG8_SB(1, 0), cB + kstep, voffB); PG8_STAGE(PG8_SA(1, 0), cA + kstep, voffA); PG8_STAGE(PG8_SB(1, 1), cB + hstep + kstep, voffB);
        PG8_WAIT_V(6); PG8_BAR;
    }
    for (;;) {
        const bool has_next = S.next(ui + 1, nxt);
        const char* nA = has_next ? (const char*)g.A + (size_t)S.arow(nxt) * tstep : cA; const char* nB = has_next ? (const char*)g.Bt + (size_t)nxt.pn * tstep : cB;
        for (int t = 0; t < nt; t += 2) {
            const bool last = (t == nt - 2);
            const char* a1 = cA + (size_t)(t + 1) * kstep;
            const char* a2 = last ? nA : cA + (size_t)(t + 2) * kstep; const char* b2 = last ? nB : cB + (size_t)(t + 2) * kstep;
            const char* a3 = a2 + kstep; const char* b3 = b2 + kstep;
            if (last && has_next) S.a_ready(nxt);
            if constexpr (SP2) {
            PG8_LDB(B0, 0, 0); PG8_LDB(B1, 0, 1); PG8_SCHED; PG8_LDA(At, 0, 0); PG8_STAGE(PG8_SA(1, 1), a1 + hstep, voffA);
            PG8_WAIT_V(8); PG8_WAIT_L(0); PG8_BAR; PG8_MMA(0, 0, At, B0); PG8_MMA(0, 1, At, B1); PG8_BAR; PG8_SCHED;
            PG8_LDA(At, 0, 1); PG8_STAGE(PG8_SB(0, 0), b2, voffB); PG8_STAGE(PG8_SB(0, 1), b2 + hstep, voffB); PG8_STAGE(PG8_SA(0, 0), a2, voffA);
            PG8_WAIT_V(8); PG8_WAIT_L(0); PG8_BAR; PG8_MMA(1, 0, At, B0); PG8_MMA(1, 1, At, B1); PG8_BAR; PG8_SCHED;
            PG8_LDB(B0, 1, 0); PG8_LDB(B1, 1, 1); PG8_SCHED; PG8_LDA(At, 1, 0); PG8_STAGE(PG8_SA(0, 1), a2 + hstep, voffA);
            PG8_WAIT_V(8); PG8_WAIT_L(0); PG8_BAR; PG8_MMA(0, 0, At, B0); PG8_MMA(0, 1, At, B1); PG8_BAR; PG8_SCHED;
            PG8_LDA(At, 1, 1); PG8_STAGE(PG8_SB(1, 0), b3, voffB); PG8_STAGE(PG8_SB(1, 1), b3 + hstep, voffB); PG8_STAGE(PG8_SA(1, 0), a3, voffA);
            PG8_WAIT_V(8); PG8_WAIT_L(0); PG8_BAR; PG8_MMA(1, 0, At, B0); PG8_MMA(1, 1, At, B1); PG8_BAR; PG8_SCHED;
            } else {
            PG8_LDB(B0, 0, 0); PG8_SCHED; PG8_LDA(At, 0, 0); PG8_STAGE(PG8_SA(1, 1), a1 + hstep, voffA);
            PG8_WAIT_L(8); PG8_BAR; PG8_WAIT_L(0); PG8_MMA(0, 0, At, B0); PG8_BAR; PG8_SCHED;
            PG8_LDB(B1, 0, 1); PG8_STAGE(PG8_SB(0, 0), b2, voffB);
            PG8_BAR; PG8_WAIT_L(0); PG8_MMA(0, 1, At, B1); PG8_BAR;
            PG8_LDA(At, 0, 1); PG8_STAGE(PG8_SA(0, 0), a2, voffA);
            PG8_BAR; PG8_WAIT_L(0); PG8_MMA(1, 0, At, B0); PG8_BAR; PG8_SCHED;
            PG8_STAGE(PG8_SB(0, 1), b2 + hstep, voffB);
            PG8_WAIT_V(6); PG8_BAR; PG8_MMA(1, 1, At, B1); PG8_BAR;
            PG8_LDB(B0, 1, 0); PG8_SCHED; PG8_LDA(At, 1, 0); PG8_STAGE(PG8_SA(0, 1), a2 + hstep, voffA);
            PG8_WAIT_L(8); PG8_BAR; PG8_WAIT_L(0); PG8_MMA(0, 0, At, B0); PG8_BAR; PG8_SCHED;
            PG8_LDB(B1, 1, 1); PG8_STAGE(PG8_SB(1, 0), b3, voffB);
            PG8_BAR; PG8_WAIT_L(0); PG8_MMA(0, 1, At, B1); PG8_BAR;
            PG8_LDA(At, 1, 1); PG8_STAGE(PG8_SA(1, 0), a3, voffA);
            PG8_BAR; PG8_WAIT_L(0); PG8_MMA(1, 0, At, B0); PG8_BAR; PG8_SCHED;
            PG8_STAGE(PG8_SB(1, 1), b3 + hstep, voffB);
            PG8_WAIT_V(6); PG8_BAR; PG8_MMA(1, 1, At, B1); PG8_BAR;
            }
        }
        if constexpr (ALIGN_EPI) { if (wr == 0) PG8_BAR; }
        if constexpr (!Epi::AFTER_DRAIN) { E(acc, cur, wr, wc, fr, fq); S.done(cur); }
        if (!has_next) break;
#pragma unroll
        for (int a = 0; a < 2; ++a)
#pragma unroll
            for (int b = 0; b < 2; ++b)
#pragma unroll
                for (int m = 0; m < 4; ++m)
#pragma unroll
                    for (int n = 0; n < 2; ++n) acc[a][b][m][n] = (f32x4){0.f, 0.f, 0.f, 0.f};
        cur = nxt; cA = nA; cB = nB; ++ui;
        if constexpr (ALIGN_EPI) { if (wr == 1) PG8_BAR; }
    }
    PG8_WAIT_V(0);
    if constexpr (!ALIGN_EPI) { if (wr == 0) PG8_BAR; }
    PG8_BAR;
    if constexpr (Epi::AFTER_DRAIN) { E.fused(acc, cur, wr, wc, fr, fq, lds, wid, lane); S.done(cur); }
#undef PG8_SA
#undef PG8_SB
#undef PG8_STAGE
#undef PG8_LDA
#undef PG8_LDB
#undef PG8_MMA
#undef PG8_WAIT_V
#undef PG8_WAIT_L
#undef PG8_BAR
#undef PG8_SCHED
}
}
constexpr int NWAVES = 8;
constexpr int DM = 1024, NB = 8, SEQ = 2048, CTXL = 256, MX = NB * SEQ, MC = NB * CTXL, MT = MX + MC;
constexpr int INC = 3840, DFF = 2816, PXW = 2816, NMODC = 6 * DM;
constexpr float LN_EPS = 1e-6f, ALPHA = 1.4142135623730951f;
constexpr int PXC_V = 0, PXC_Q = 512, PXC_G = 1024, PXC_GB = 1536, PXC_GC = 1792, PXC_HS = 2048, PXC_U = 2304, PXC_VS = 2560;

constexpr size_t MiB = 1u << 20;
constexpr size_t WS_CTL = 0, CTL_ZERO_BYTES = 512 * 1024;
constexpr size_t WS_MOD = 512 * 1024;
constexpr size_t WS_LBV = WS_MOD + 448 * 1024;
constexpr size_t WS_WIN = 1 * MiB, WS_WOUT = WS_WIN + (size_t)INC * DM * 2, WS_WUP = WS_WOUT + (size_t)DM * DM * 2, WS_WDN = WS_WUP + (size_t)2 * DFF * DM * 2;
constexpr size_t WS_XM = 27 * MiB;
constexpr size_t WS_PX = 63 * MiB;
constexpr size_t WS_LF = 162 * MiB;
constexpr size_t WS_OB = 234 * MiB;
constexpr size_t WS_CTXR = 248 * MiB;
constexpr size_t WS_END = 256 * MiB;
static_assert(WS_WDN + (size_t)DM * DFF * 2 <= WS_XM && WS_XM + (size_t)MT * DM * 2 <= WS_PX && WS_PX + (size_t)MT * PXW * 2 <= WS_LF && WS_LF + (size_t)MT * DM * 4 <= WS_OB && WS_OB + (size_t)MT * 512 * 2 <= WS_END && WS_CTXR + (size_t)MC * DM * 4 <= WS_END, "ws map");
static_assert(WS_PX + 2 * (size_t)MX * DFF * 2 <= WS_END, "A_buf|G_buf for 16384 rows (layer 1: LF, OB, CTXR are dead then)");
constexpr int CW_BAR = 4096;

constexpr int RING_OFF = 0, RING_BYTES = 131072;
constexpr int LDSCTL_OFF = RING_BYTES, MISC_OFF = LDSCTL_OFF + 320;
constexpr int LDS_BYTES = 147456;
#define GAS __attribute__((address_space(1)))
#define LAS __attribute__((address_space(3)))
typedef unsigned short bf16;
typedef unsigned v4u __attribute__((ext_vector_type(4)));
typedef float f32x4 __attribute__((ext_vector_type(4)));
typedef short bf16x8 __attribute__((ext_vector_type(8)));
typedef GAS unsigned gu32;
typedef GAS unsigned long long gu64;
#define RLX_AGENT __ATOMIC_RELAXED, __HIP_MEMORY_SCOPE_AGENT
#define LDS_WAIT() asm volatile("s_waitcnt lgkmcnt(0)" ::: "memory")
#define VM_WAIT() asm volatile("s_waitcnt vmcnt(0)" ::: "memory")
__device__ __forceinline__ unsigned long long rt() { return __builtin_amdgcn_s_memrealtime(); }
__device__ __forceinline__ unsigned f2bf(float f) { unsigned u = __builtin_bit_cast(unsigned, f); return (u + 0x7fffu + ((u >> 16) & 1u)) >> 16; }
__device__ __forceinline__ unsigned pk2(float lo, float hi) { return f2bf(lo) | (f2bf(hi) << 16); }

#define XB_TMO      128
#define XB_XCNT(j)  (256  + 64 * (j))
#define XB_XSUB(j)  (1280 + 64 * (j))
#define XB_XGEN(j)  (2304 + 64 * (j))
#define XB_TOP      3328
#define XB_TOPGEN   3392
#define XCD_BAR_WORDS 3456
#define XB_SPIN_CAP (1u << 28)

__device__ __forceinline__ unsigned xb_ld(unsigned* p)              { return __hip_atomic_load(p, __ATOMIC_RELAXED, __HIP_MEMORY_SCOPE_AGENT); }
__device__ __forceinline__ unsigned xb_add(unsigned* p, unsigned v) { return __hip_atomic_fetch_add(p, v, __ATOMIC_RELAXED, __HIP_MEMORY_SCOPE_AGENT); }
__device__ __forceinline__ unsigned xb_xcc_id() { return (unsigned)__builtin_amdgcn_s_getreg((3 << 11) | 20) & 0xFu; }
#define XB_SPIN(cond, bar) do { unsigned _sp = 0; while (cond) { __builtin_amdgcn_s_sleep(1); \
    if ((++_sp & 255u) == 0u) { if (xb_ld(&(bar)[XB_TMO])) break; if (_sp > XB_SPIN_CAP) { atomicAdd(&(bar)[XB_TMO], 1u); break; } } } } while (0)

struct XcdBarrier {
    unsigned* bar; unsigned x;
    volatile LAS unsigned* st;
};

__device__ __forceinline__ XcdBarrier xcd_barrier_post(unsigned* bar, volatile LAS unsigned* st) {
    XcdBarrier b; b.bar = bar; b.x = xb_xcc_id(); b.st = st;
    if (threadIdx.x == 0) (void)xb_add(&bar[XB_XCNT(b.x)], 1u);
    return b;
}
__device__ __forceinline__ void xcd_barrier_complete(unsigned* bar, unsigned x, unsigned& nloc, unsigned& nx) {
    const unsigned G = gridDim.x * gridDim.y * gridDim.z;
    unsigned sum, cnt, mine, sp = 0u;
    for (;;) {
        sum = 0u; cnt = 0u; mine = 0u;
#pragma unroll
        for (unsigned j = 0; j < 16; ++j) { const unsigned c = xb_ld(&bar[XB_XCNT(j)]); sum += c; cnt += (c > 0u) ? 1u : 0u; mine = (j == x) ? c : mine; }
        if (sum == G) break;
        __builtin_amdgcn_s_sleep(1);
        if ((++sp & 255u) == 0u) { if (xb_ld(&bar[XB_TMO])) break; if (sp > XB_SPIN_CAP) { atomicAdd(&bar[XB_TMO], 1u); break; } }
    }
    nloc = mine > 0u ? mine : 1u; nx = cnt > 0u ? cnt : 1u;
}

__device__ __forceinline__ void xcd_barrier(const XcdBarrier& b, const int tid) {
    asm volatile("s_waitcnt vmcnt(0)" ::: "memory");
    __syncthreads();
    if (tid == 0) {
        unsigned* bar = b.bar;
        __builtin_amdgcn_s_waitcnt(0);
        unsigned nloc = b.st[0], nx = b.st[1];
        if (nloc == 0u) { xcd_barrier_complete(bar, b.x, nloc, nx); b.st[0] = nloc; b.st[1] = nx; }
        const unsigned old = xb_add(&bar[XB_XSUB(b.x)], 1u);
        const unsigned gen = old / nloc;
        if (old + 1u == (gen + 1u) * nloc) {
            __builtin_amdgcn_fence(__ATOMIC_RELEASE, "agent");
            asm volatile("s_waitcnt vmcnt(0)" ::: "memory");
            const unsigned og = xb_add(&bar[XB_TOP], 1u);
            const unsigned tg = og / nx;
            if (og + 1u == (tg + 1u) * nx) xb_add(&bar[XB_TOPGEN], 1u);
            else XB_SPIN(xb_ld(&bar[XB_TOPGEN]) == tg, bar);
            __builtin_amdgcn_fence(__ATOMIC_ACQUIRE, "agent");
            xb_add(&bar[XB_XGEN(b.x)], 1u);
            asm volatile("s_waitcnt vmcnt(0)" ::: "memory");
        } else {
            XB_SPIN(xb_ld(&bar[XB_XGEN(b.x)]) == gen, bar);
            __builtin_amdgcn_fence(__ATOMIC_ACQUIRE, "agent");
            asm volatile("s_waitcnt vmcnt(0)" ::: "memory");
        }
    }
    __syncthreads();
}

struct Frame {
    LAS unsigned char* lds;
    volatile LAS unsigned* MISC;
    gu32* ctl;
    int tid, lane, wave, vcu, G;
    float* out;
    unsigned char* ws;
};
__device__ __forceinline__ const float* inptr(int i) { asm volatile("" : "+s"(i)); return *(const float* const*)((const char __attribute__((address_space(4)))*)__builtin_amdgcn_kernarg_segment_ptr() + 8 * i); }
#define IN_X inptr(0)
#define IN_C inptr(1)
#define IN_CTX inptr(2)
#define IN_C_CTX inptr(3)
#define IN_ADA_W inptr(4)
#define IN_ADA_B inptr(5)
#define IN_W_IN inptr(6)
#define IN_HG_LB inptr(7)
#define IN_HG_NORM_G inptr(8)
#define IN_SC_CONV_W inptr(9)
#define IN_SG_LN_G inptr(10)
#define IN_SG_LN_B inptr(11)
#define IN_SG_W inptr(12)
#define IN_SG_B inptr(13)
#define IN_W_OUT inptr(14)
#define IN_LN1_G inptr(15)
#define IN_LN1_B inptr(16)
#define IN_FFN_UP inptr(17)
#define IN_FFN_CONV_W inptr(18)
#define IN_FFN_CONV_B inptr(19)
#define IN_FFN_DOWN inptr(20)
#define IN_LN2_G inptr(21)
#define IN_LN2_B inptr(22)
typedef float f32x2 __attribute__((ext_vector_type(2)));
typedef unsigned u32x2 __attribute__((ext_vector_type(2)));
#define WGBAR() do { asm volatile("s_waitcnt vmcnt(0) lgkmcnt(0)" ::: "memory"); __builtin_amdgcn_s_barrier(); asm volatile("" ::: "memory"); } while (0)
#define LBAR() do { asm volatile("s_waitcnt lgkmcnt(0)" ::: "memory"); __builtin_amdgcn_s_barrier(); asm volatile("" ::: "memory"); } while (0)
__device__ __forceinline__ float wave_sum(float v) {
#pragma unroll
    for (int o = 1; o < 64; o <<= 1) v += __shfl_xor(v, o);
    return v;
}
__device__ __forceinline__ unsigned cvtpk(float lo, float hi) { return pg8::cvt_pk_bf16(lo, hi); }
__device__ __forceinline__ float bflo(unsigned u) { return __uint_as_float(u << 16); }
__device__ __forceinline__ float bfhi(unsigned u) { return __uint_as_float(u & 0xffff0000u); }
__device__ __forceinline__ float bf1(unsigned short u) { return __uint_as_float(((unsigned)u) << 16); }
__device__ __forceinline__ float siluf(float v) { return v / (1.f + __expf(-v)); }

__device__ __forceinline__ void p0_transpose_item(const float* W, int K, int N, bf16* WT, LAS float* scr, int item, int lane) {
    const int nblk = N / 32, kb = item / nblk, nb = item % nblk, k0 = 64 * kb, n0 = 32 * nb;
#pragma unroll 8
    for (int i = 0; i < 32; ++i) { const int kk = 2 * i + (lane >> 5); scr[kk * 33 + (lane & 31)] = W[(size_t)(k0 + kk) * N + n0 + (lane & 31)]; }
    LDS_WAIT(); asm volatile("" ::: "memory");
    const int c = lane & 7;
#pragma unroll
    for (int j = 0; j < 4; ++j) { const int n = (lane >> 3) + 8 * j; const LAS float* s = scr + (8 * c) * 33 + n;
        v4u o; o.x = pk2(s[0 * 33], s[1 * 33]); o.y = pk2(s[2 * 33], s[3 * 33]); o.z = pk2(s[4 * 33], s[5 * 33]); o.w = pk2(s[6 * 33], s[7 * 33]);
        *(GAS v4u*)(WT + (size_t)(n0 + n) * K + k0 + 8 * c) = o; }
    LDS_WAIT(); asm volatile("" ::: "memory");
}
__device__ __forceinline__ void convert_weights(Frame& F, int layer, int which) {
    LAS float* scr = (LAS float*)(F.lds + RING_OFF + F.wave * 16384);
    const int gw = F.vcu * NWAVES + F.wave, NGW = F.G * NWAVES;
    const float* const p_win = IN_W_IN; const float* const p_wout = IN_W_OUT; const float* const p_up = IN_FFN_UP; const float* const p_dn = IN_FFN_DOWN;
    constexpr int I_IN = (DM / 64) * (INC / 32), I_OUT = (DM / 64) * (DM / 32), I_UP = (DM / 64) * (2 * DFF / 32), I_DN = (DFF / 64) * (DM / 32);
    if (which & 1) {
        for (int it = gw; it < I_IN + I_OUT; it += NGW) {
            if (it < I_IN) p0_transpose_item(p_win + (size_t)layer * DM * INC, DM, INC, (bf16*)(F.ws + WS_WIN), scr, it, F.lane);
            else p0_transpose_item(p_wout + (size_t)layer * DM * DM, DM, DM, (bf16*)(F.ws + WS_WOUT), scr, it - I_IN, F.lane);
        }
    }
    if (which & 2) {
        for (int it = gw; it < I_UP + I_DN; it += NGW) {
            if (it < I_UP) p0_transpose_item(p_up + (size_t)layer * DM * 2 * DFF, DM, 2 * DFF, (bf16*)(F.ws + WS_WUP), scr, it, F.lane);
            else p0_transpose_item(p_dn + (size_t)layer * DFF * DM, DFF, DM, (bf16*)(F.ws + WS_WDN), scr, it - I_UP, F.lane);
        }
    }
}
__device__ __forceinline__ void p0_mod(Frame& F) {
    LAS float* sc = (LAS float*)(F.lds);
    LAS float* red = (LAS float*)(F.lds + 40960);
    float* mod = (float*)(F.ws + WS_MOD);
    const float* const p_c = IN_C; const float* const p_cc = IN_C_CTX; const float* const p_aw = IN_ADA_W; const float* const p_ab = IN_ADA_B; const float* const p_lb = IN_HG_LB;
    for (int idx = F.tid; idx < 9 * 1024; idx += 512) { const int r = idx >> 10, k = idx & 1023; const float v = r < 8 ? p_c[r * 1024 + k] : p_cc[k]; sc[idx] = siluf(v); }
    WGBAR();
    for (int item = F.vcu; item < 192; item += F.G) {
        const int l = item / 96, n0 = (item % 96) * 64;
        const float* W = p_aw + (size_t)l * DM * NMODC + n0 + F.lane; const int k0 = F.wave * 128;
        float acc[9];
#pragma unroll
        for (int r = 0; r < 9; ++r) acc[r] = 0.f;
        for (int k = k0; k < k0 + 128; k += 8) {
            float wv[8];
#pragma unroll
            for (int i = 0; i < 8; ++i) wv[i] = W[(size_t)(k + i) * NMODC];
#pragma unroll
            for (int i = 0; i < 8; ++i)
#pragma unroll
                for (int r = 0; r < 9; ++r) acc[r] += sc[r * 1024 + k + i] * wv[i];
        }
#pragma unroll
        for (int r = 0; r < 9; ++r) red[(F.wave * 9 + r) * 64 + F.lane] = acc[r];
        WGBAR();
        for (int o = F.tid; o < 576; o += 512) { const int r = o >> 6, col = o & 63; float s = 0.f;
#pragma unroll
            for (int w = 0; w < 8; ++w) s += red[(w * 9 + r) * 64 + col];
            mod[(size_t)(l * 9 + r) * NMODC + n0 + col] = s + p_ab[l * NMODC + n0 + col]; }
        WGBAR();
    }
    if (F.vcu == F.G - 1) { float* lbv = (float*)(F.ws + WS_LBV);
        for (int i = F.tid; i < 1024; i += 512) { lbv[i] = 0.f; lbv[1024 + i] = 1.f / (1.f + __expf(-(p_lb[1024 + i] - p_lb[i]))); } }
}
__device__ __forceinline__ void row_stats(const f32x4 (&v)[4], float& mean, float& rstd) {
    float s = 0.f;
#pragma unroll
    for (int j = 0; j < 4; ++j) s += (v[j].x + v[j].y) + (v[j].z + v[j].w);
    mean = wave_sum(s) * (1.f / DM); float s2 = 0.f;
#pragma unroll
    for (int j = 0; j < 4; ++j) { const f32x4 d = v[j] - mean; s2 += (d.x * d.x + d.y * d.y) + (d.z * d.z + d.w * d.w); }
    rstd = 1.f / sqrtf(wave_sum(s2) * (1.f / DM) + LN_EPS);
}
__device__ __forceinline__ void modulate_store(const f32x4 (&v)[4], const float* shift, const float* scale, bf16* orow, int lane) {
    float mean, rstd; row_stats(v, mean, rstd);
#pragma unroll
    for (int j = 0; j < 4; ++j) { const f32x4 sh = *(const f32x4*)(shift + 4 * lane + 256 * j), sc = *(const f32x4*)(scale + 4 * lane + 256 * j);
        const f32x4 y = (v[j] - mean) * rstd * (sc + 1.f) + sh; u32x2 w; w.x = cvtpk(y.x, y.y); w.y = cvtpk(y.z, y.w);
        *(u32x2*)(orow + 4 * lane + 256 * j) = w; }
}
__device__ __forceinline__ const float* mod_row(Frame& F, int layer, int row) { return (const float*)(F.ws + WS_MOD) + (size_t)(layer * 9 + (row < MX ? row / SEQ : 8)) * NMODC; }
__device__ __forceinline__ void phase_r1(Frame& F) {
    const int gw = F.vcu * NWAVES + F.wave, NGW = F.G * NWAVES; bf16* XM = (bf16*)(F.ws + WS_XM); const float* const p_x = IN_X; const float* const p_ctx = IN_CTX;
    for (int row = gw; row < MT; row += NGW) {
        const float* src = row < MX ? p_x + (size_t)row * DM : p_ctx + (size_t)(row - MX) * DM; const float* md = mod_row(F, 0, row);
        f32x4 v[4];
#pragma unroll
        for (int j = 0; j < 4; ++j) v[j] = *(const f32x4*)(src + 4 * F.lane + 256 * j);
        modulate_store(v, md, md + DM, XM + (size_t)row * DM, F.lane);
    }
}
__device__ __forceinline__ void phase_r2(Frame& F, int layer) {
    const int gw = F.vcu * NWAVES + F.wave, NGW = F.G * NWAVES; bf16* XM = (bf16*)(F.ws + WS_XM); const float* Y = (const float*)(F.ws + WS_LF);
    const int nrows = layer == 0 ? MT : MX; const float* g1 = IN_LN1_G + layer * DM; const float* b1 = IN_LN1_B + layer * DM; const float* const p_x = IN_X; const float* const p_ctx = IN_CTX;
    for (int row = gw; row < nrows; row += NGW) {
        const float* res = layer == 0 ? (row < MX ? p_x + (size_t)row * DM : p_ctx + (size_t)(row - MX) * DM) : F.out + (size_t)row * DM;
        float* dst = row < MX ? F.out + (size_t)row * DM : (float*)(F.ws + WS_CTXR) + (size_t)(row - MX) * DM;
        const float* md = mod_row(F, layer, row);
        f32x4 v[4];
#pragma unroll
        for (int j = 0; j < 4; ++j) { const int o = 4 * F.lane + 256 * j; const f32x4 r = *(const f32x4*)(res + o), y = *(const f32x4*)(Y + (size_t)row * DM + o), g = *(const f32x4*)(md + 2 * DM + o); v[j] = r * ALPHA + g * y; }
        float mean, rstd; row_stats(v, mean, rstd);
#pragma unroll
        for (int j = 0; j < 4; ++j) { const int o = 4 * F.lane + 256 * j; v[j] = (v[j] - mean) * rstd * *(const f32x4*)(g1 + o) + *(const f32x4*)(b1 + o); *(f32x4*)(dst + o) = v[j]; }
        modulate_store(v, md + 3 * DM, md + 4 * DM, XM + (size_t)row * DM, F.lane);
    }
}
__device__ __forceinline__ void phase_r3(Frame& F, int layer, int nT, int split, int off1, int off2) {
    const int gw = F.vcu * NWAVES + F.wave, NGW = F.G * NWAVES; bf16* XM = (bf16*)(F.ws + WS_XM); const float* Y2 = (const float*)(F.ws + WS_PX);
    const float* g2 = IN_LN2_G + layer * DM; const float* b2 = IN_LN2_B + layer * DM;
    for (int cr = gw; cr < nT * 256; cr += NGW) {
        const int ci = cr >> 8, row = ((ci + (ci < split ? off1 : off2)) << 8) + (cr & 255);
        float* xr = row < MX ? F.out + (size_t)row * DM : (float*)(F.ws + WS_CTXR) + (size_t)(row - MX) * DM;
        const float* md = mod_row(F, layer, row);
        f32x4 v[4];
#pragma unroll
        for (int j = 0; j < 4; ++j) { const int o = 4 * F.lane + 256 * j; const f32x4 r = *(const f32x4*)(xr + o), y = *(const f32x4*)(Y2 + (size_t)cr * DM + o), g = *(const f32x4*)(md + 5 * DM + o); v[j] = r * ALPHA + g * y; }
        float mean, rstd; row_stats(v, mean, rstd);
#pragma unroll
        for (int j = 0; j < 4; ++j) { const int o = 4 * F.lane + 256 * j; v[j] = (v[j] - mean) * rstd * *(const f32x4*)(g2 + o) + *(const f32x4*)(b2 + o); if (row < MX) *(f32x4*)(xr + o) = v[j]; }
        if (layer == 0) { const float* md1 = mod_row(F, 1, row); modulate_store(v, md1, md1 + DM, XM + (size_t)row * DM, F.lane); }
    }
}
#define MFMA16(a, b, c) __builtin_amdgcn_mfma_f32_16x16x32_bf16((a), (b), (c), 0, 0, 0)
__device__ __forceinline__ float one_minus_exp(float x) { const float s = -x * (1.f + x * (0.5f + x * (0.16666667f + x * 0.041666668f))); return x < -0.1f ? 1.f - __expf(x) : s; }
constexpr int HG_QP = 0, HG_KP = 17408, HG_KT = 34816, HG_VT = 53248, HG_ST = 71680, HG_AS = 106496, HG_T = 115712, HG_CV = 119808, HG_END = 121344;
static_assert(HG_END <= RING_BYTES, "hgrn lds");
__device__ __forceinline__ void hgrn_scan(Frame& F, int layer, int item) {
    const int b = item >> 3, h = (item >> 1) & 3, dir = item & 1;
    LAS unsigned char* L = F.lds;
    const int lane = F.lane, w = F.wave, l15 = lane & 15, lq = lane >> 4;
    const float* LFp = (const float*)(F.ws + WS_LF) + dir * 512 + h * 128 + 2 * lane;
    const bf16* PX = (const bf16*)(F.ws + WS_PX);
    const bf16* Qp = PX + PXC_Q + h * 128 + 2 * lane;
    const bf16* Vp = PX + PXC_V + h * 128 + 2 * lane;
    bf16* Of = (bf16*)(F.ws + WS_XM);
    bf16* Ob = (bf16*)(F.ws + WS_OB);
    f32x4 S[8];
#pragma unroll
    for (int i = 0; i < 8; ++i) S[i] = (f32x4){0.f, 0.f, 0.f, 0.f};
    f32x2 lf[8]; unsigned qv[8], vv[8];
#define HG_BASE(s) ((s) < 4 ? MX + b * CTXL + (dir ? 3 - (s) : (s)) * 64 : b * SEQ + (dir ? 35 - (s) : (s) - 4) * 64)
#define HG_LOAD(s) do { const int base_ = HG_BASE(s); const bool wq_ = ((s) >= 4) || layer == 0; \
        _Pragma("unroll") for (int r = 0; r < 8; ++r) { const int row_ = base_ + (dir ? 63 - 8 * w - r : 8 * w + r); \
            lf[r] = *(const f32x2*)(LFp + (size_t)row_ * 1024); vv[r] = *(const unsigned*)(Vp + (size_t)row_ * PXW); } \
        if (wq_) { _Pragma("unroll") for (int r = 0; r < 8; ++r) { const int row_ = base_ + (dir ? 63 - 8 * w - r : 8 * w + r); qv[r] = *(const unsigned*)(Qp + (size_t)row_ * PXW); } } \
        else { _Pragma("unroll") for (int r = 0; r < 8; ++r) qv[r] = 0u; } } while (0)
    HG_LOAD(0);
    for (int s = 0; s < 36; ++s) {
        const int base = HG_BASE(s); const bool wanto = (s >= 4) || layer == 0;
        f32x2 cs[8]; f32x2 run = (f32x2){0.f, 0.f};
#pragma unroll
        for (int r = 0; r < 8; ++r) { run = run + lf[r]; cs[r] = run; }
        *(LAS f32x2*)(L + HG_T + (w * 128 + 2 * lane) * 4) = run;
        LBAR();
        f32x2 P = (f32x2){0.f, 0.f}, mm = P, bl = P;
#pragma unroll
        for (int j = 0; j < 8; ++j) { const f32x2 t = *(const LAS f32x2*)(L + HG_T + (j * 128 + 2 * lane) * 4); if (j < w) P = P + t; if (j < 4) mm = mm + t; bl = bl + t; }
        unsigned kc0[4], kc1[4], vc0[4], vc1[4];
        float kprev0 = 0.f, kprev1 = 0.f;
#pragma unroll
        for (int r = 0; r < 8; ++r) {
            const f32x2 bb = P + cs[r];
            const float e1x = __expf(bb.x - mm.x), e1y = __expf(bb.y - mm.y), e2x = __expf(mm.x - bb.x), e2y = __expf(mm.y - bb.y);
            const float kx = one_minus_exp(lf[r].x) * e2x, ky = one_minus_exp(lf[r].y) * e2y;
            const int tau = 8 * w + r;
            *(LAS unsigned*)(L + HG_QP + tau * 272 + lane * 4) = cvtpk(bflo(qv[r]) * e1x, bfhi(qv[r]) * e1y);
            *(LAS unsigned*)(L + HG_KP + tau * 272 + lane * 4) = cvtpk(kx, ky);
            if (r & 1) { kc0[r >> 1] = cvtpk(kprev0, kx); kc1[r >> 1] = cvtpk(kprev1, ky);
                         vc0[r >> 1] = (vv[r - 1] & 0xffffu) | (vv[r] << 16); vc1[r >> 1] = (vv[r - 1] >> 16) | (vv[r] & 0xffff0000u); }
            else { kprev0 = kx; kprev1 = ky; }
        }
        *(LAS v4u*)(L + HG_KT + (2 * lane) * 144 + w * 16) = (v4u){kc0[0], kc0[1], kc0[2], kc0[3]};
        *(LAS v4u*)(L + HG_KT + (2 * lane + 1) * 144 + w * 16) = (v4u){kc1[0], kc1[1], kc1[2], kc1[3]};
        *(LAS v4u*)(L + HG_VT + (2 * lane) * 144 + w * 16) = (v4u){vc0[0], vc0[1], vc0[2], vc0[3]};
        *(LAS v4u*)(L + HG_VT + (2 * lane + 1) * 144 + w * 16) = (v4u){vc1[0], vc1[1], vc1[2], vc1[3]};
        if (w == 0) {
            *(LAS f32x2*)(L + HG_CV + (0 * 128 + 2 * lane) * 4) = (f32x2){__expf(mm.x), __expf(mm.y)};
            *(LAS f32x2*)(L + HG_CV + (1 * 128 + 2 * lane) * 4) = (f32x2){__expf(bl.x - mm.x), __expf(bl.y - mm.y)};
            *(LAS f32x2*)(L + HG_CV + (2 * 128 + 2 * lane) * 4) = (f32x2){__expf(bl.x), __expf(bl.y)};
        }
        if (s + 1 < 36) HG_LOAD(s + 1);
        LBAR();
        if (wanto) {
#pragma unroll
            for (int kt = 0; kt < 8; ++kt) { const f32x4 em = *(const LAS f32x4*)(L + HG_CV + (16 * kt + 4 * lq) * 4); const f32x4 sv = S[kt] * em;
                *(LAS u32x2*)(L + HG_ST + (16 * w + l15) * 272 + (16 * kt + 4 * lq) * 2) = (u32x2){cvtpk(sv.x, sv.y), cvtpk(sv.z, sv.w)}; }
            const int ti = w >> 1;
#pragma unroll
            for (int sx = 0; sx < 2; ++sx) { const int si = 2 * (w & 1) + sx; f32x4 a = (f32x4){0.f, 0.f, 0.f, 0.f};
                if (si <= ti) {
#pragma unroll
                    for (int ks = 0; ks < 4; ++ks) { const bf16x8 qa = *(const LAS bf16x8*)(L + HG_QP + (16 * ti + l15) * 272 + (32 * ks + 8 * lq) * 2);
                        const bf16x8 kb = *(const LAS bf16x8*)(L + HG_KP + (16 * si + l15) * 272 + (32 * ks + 8 * lq) * 2); a = MFMA16(qa, kb, a); }
                }
#pragma unroll
                for (int r = 0; r < 4; ++r) { const int tau = 16 * ti + 4 * lq + r, sig = 16 * si + l15; const float val = (si <= ti && sig <= tau) ? a[r] : 0.f;
                    *(LAS unsigned short*)(L + HG_AS + tau * 144 + sig * 2) = (unsigned short)(cvtpk(val, 0.f) & 0xffffu); }
            }
        }
        LBAR();
        bf16x8 bv[2];
#pragma unroll
        for (int ks = 0; ks < 2; ++ks) bv[ks] = *(const LAS bf16x8*)(L + HG_VT + (16 * w + l15) * 144 + (32 * ks + 8 * lq) * 2);
        if (wanto) {
            bf16x8 bs[4];
#pragma unroll
            for (int ks = 0; ks < 4; ++ks) bs[ks] = *(const LAS bf16x8*)(L + HG_ST + (16 * w + l15) * 272 + (32 * ks + 8 * lq) * 2);
#pragma unroll
            for (int ti = 0; ti < 4; ++ti) { f32x4 a = (f32x4){0.f, 0.f, 0.f, 0.f};
#pragma unroll
                for (int ks = 0; ks < 2; ++ks) { const bf16x8 aa = *(const LAS bf16x8*)(L + HG_AS + (16 * ti + l15) * 144 + (32 * ks + 8 * lq) * 2); a = MFMA16(aa, bv[ks], a); }
#pragma unroll
                for (int ks = 0; ks < 4; ++ks) { const bf16x8 qa = *(const LAS bf16x8*)(L + HG_QP + (16 * ti + l15) * 272 + (32 * ks + 8 * lq) * 2); a = MFMA16(qa, bs[ks], a); }
#pragma unroll
                for (int r = 0; r < 4; ++r) { const int tau = 16 * ti + 4 * lq + r; const int row = base + (dir ? 63 - tau : tau); const unsigned short ov = (unsigned short)(cvtpk(a[r], 0.f) & 0xffffu);
                    if (dir) Ob[(size_t)row * 512 + h * 128 + 16 * w + l15] = ov; else Of[(size_t)row * DM + h * 128 + 16 * w + l15] = ov; }
            }
        }
#pragma unroll
        for (int kt = 0; kt < 8; ++kt) { f32x4 u = (f32x4){0.f, 0.f, 0.f, 0.f};
#pragma unroll
            for (int ks = 0; ks < 2; ++ks) { const bf16x8 ka = *(const LAS bf16x8*)(L + HG_KT + (16 * kt + l15) * 144 + (32 * ks + 8 * lq) * 2); u = MFMA16(ka, bv[ks], u); }
            const f32x4 eu = *(const LAS f32x4*)(L + HG_CV + (128 + 16 * kt + 4 * lq) * 4), d = *(const LAS f32x4*)(L + HG_CV + (256 + 16 * kt + 4 * lq) * 4);
            S[kt] = d * S[kt] + eu * u; }
        LBAR();
    }
#undef HG_LOAD
#undef HG_BASE
}
constexpr int SG_WS = 0, SG_VH = 34816, SG_END = 34816 + 64 * 272;
__device__ __forceinline__ void sg_block(Frame& F, int layer, int sb) {
    const int g = sb & 3, j0 = sb >> 2, nCh = layer == 0 ? 144 : 128;
    LAS unsigned char* L = F.lds; const int lane = F.lane, w = F.wave, l15 = lane & 15, lq = lane >> 4, tid = F.tid;
    const float* Wg = IN_SG_W + ((size_t)layer * 4 + g) * 128 * 128;
#pragma unroll
    for (int i = 0; i < 8; ++i) { const int idx = tid * 4 + i * 2048, t = idx >> 7, s = idx & 127; const f32x4 v = *(const f32x4*)(Wg + idx);
        *(LAS u32x2*)(L + SG_WS + t * 272 + s * 2) = (u32x2){cvtpk(v.x, v.y), cvtpk(v.z, v.w)}; }
    LBAR();
    bf16x8 af[4];
#pragma unroll
    for (int ks = 0; ks < 4; ++ks) af[ks] = *(const LAS bf16x8*)(L + SG_WS + (16 * w + l15) * 272 + (32 * ks + 8 * lq) * 2);
    const bf16* PX = (const bf16*)(F.ws + WS_PX); bf16* MO = (bf16*)(F.ws + WS_XM);
    const float* lng = IN_SG_LN_G + layer * 256 + g * 64; const float* lnb = IN_SG_LN_B + layer * 256 + g * 64; const float* sgb = IN_SG_B + (layer * 4 + g) * 128;
    for (int ch = j0; ch < nCh; ch += 48) {
        const int rowbase = ch < 128 ? ch * 128 : MX + (ch - 128) * 128;
        { const int s = tid >> 2, p = tid & 3; const bf16* src = PX + (size_t)(rowbase + s) * PXW + PXC_VS + g * 64 + 16 * p;
          const v4u r0 = *(const v4u*)src, r1 = *(const v4u*)(src + 8); float x[16];
          x[0] = bflo(r0.x); x[1] = bfhi(r0.x); x[2] = bflo(r0.y); x[3] = bfhi(r0.y); x[4] = bflo(r0.z); x[5] = bfhi(r0.z); x[6] = bflo(r0.w); x[7] = bfhi(r0.w);
          x[8] = bflo(r1.x); x[9] = bfhi(r1.x); x[10] = bflo(r1.y); x[11] = bfhi(r1.y); x[12] = bflo(r1.z); x[13] = bfhi(r1.z); x[14] = bflo(r1.w); x[15] = bfhi(r1.w);
          float sm = 0.f;
#pragma unroll
          for (int i = 0; i < 16; ++i) sm += x[i];
          sm += __shfl_xor(sm, 1); sm += __shfl_xor(sm, 2); const float mean = sm * (1.f / 64.f); float q = 0.f;
#pragma unroll
          for (int i = 0; i < 16; ++i) { x[i] -= mean; q += x[i] * x[i]; }
          q += __shfl_xor(q, 1); q += __shfl_xor(q, 2); const float rstd = 1.f / sqrtf(q * (1.f / 64.f) + LN_EPS);
#pragma unroll
          for (int i = 0; i < 16; ++i) { const int c = 16 * p + i; const float y = x[i] * rstd * lng[c] + lnb[c];
              *(LAS unsigned short*)(L + SG_VH + c * 272 + s * 2) = (unsigned short)(cvtpk(y, 0.f) & 0xffffu); } }
        LBAR();
#pragma unroll
        for (int ct = 0; ct < 4; ++ct) { f32x4 a = (f32x4){0.f, 0.f, 0.f, 0.f};
#pragma unroll
            for (int ks = 0; ks < 4; ++ks) { const bf16x8 bfr = *(const LAS bf16x8*)(L + SG_VH + (16 * ct + l15) * 272 + (32 * ks + 8 * lq) * 2); a = MFMA16(af[ks], bfr, a); }
#pragma unroll
            for (int r = 0; r < 4; ++r) { const int t = 16 * w + 4 * lq + r, c = 16 * ct + l15; const size_t row = (size_t)(rowbase + t);
                const float uu = bf1(PX[row * PXW + PXC_U + g * 64 + c]); const float val = uu * (a[r] + sgb[t]);
                MO[row * DM + 768 + g * 64 + c] = (unsigned short)(cvtpk(val, 0.f) & 0xffffu); } }
        LBAR();
    }
}
__device__ __forceinline__ void sc_items(Frame& F, int layer, int first, int stride) {
    const bf16* PX = (const bf16*)(F.ws + WS_PX); bf16* MO = (bf16*)(F.ws + WS_XM); const float* cw = IN_SC_CONV_W + layer * 3 * 256;
    const int nrows = layer == 0 ? MT : MX;
    for (int idx = first; idx < nrows * 32; idx += stride) {
        const int row = idx >> 5, cg = idx & 31; const int t = row < MX ? (row & (SEQ - 1)) : ((row - MX) & (CTXL - 1)), T = row < MX ? SEQ : CTXL;
        const bf16* p = PX + (size_t)row * PXW + 8 * cg;
        const v4u gb = *(const v4u*)(p + PXC_GB), gc1 = *(const v4u*)(p + PXC_GC), h1 = *(const v4u*)(p + PXC_HS);
        v4u gc0 = (v4u){0u, 0u, 0u, 0u}, h0 = gc0, gc2 = gc0, h2 = gc0;
        if (t > 0) { gc0 = *(const v4u*)(p - PXW + PXC_GC); h0 = *(const v4u*)(p - PXW + PXC_HS); }
        if (t < T - 1) { gc2 = *(const v4u*)(p + PXW + PXC_GC); h2 = *(const v4u*)(p + PXW + PXC_HS); }
        const f32x4 w0a = *(const f32x4*)(cw + 8 * cg), w0b = *(const f32x4*)(cw + 8 * cg + 4), w1a = *(const f32x4*)(cw + 256 + 8 * cg), w1b = *(const f32x4*)(cw + 256 + 8 * cg + 4),
                    w2a = *(const f32x4*)(cw + 512 + 8 * cg), w2b = *(const f32x4*)(cw + 512 + 8 * cg + 4);
        float o[8];
#define SC_E(i, W0, W1, W2, GB, C0, H0, C1, H1, C2, H2, LO) o[i] = (LO ? bflo(GB) : bfhi(GB)) * ((W0) * (LO ? bflo(C0) * bflo(H0) : bfhi(C0) * bfhi(H0)) + (W1) * (LO ? bflo(C1) * bflo(H1) : bfhi(C1) * bfhi(H1)) + (W2) * (LO ? bflo(C2) * bflo(H2) : bfhi(C2) * bfhi(H2)))
        SC_E(0, w0a.x, w1a.x, w2a.x, gb.x, gc0.x, h0.x, gc1.x, h1.x, gc2.x, h2.x, 1); SC_E(1, w0a.y, w1a.y, w2a.y, gb.x, gc0.x, h0.x, gc1.x, h1.x, gc2.x, h2.x, 0);
        SC_E(2, w0a.z, w1a.z, w2a.z, gb.y, gc0.y, h0.y, gc1.y, h1.y, gc2.y, h2.y, 1); SC_E(3, w0a.w, w1a.w, w2a.w, gb.y, gc0.y, h0.y, gc1.y, h1.y, gc2.y, h2.y, 0);
        SC_E(4, w0b.x, w1b.x, w2b.x, gb.z, gc0.z, h0.z, gc1.z, h1.z, gc2.z, h2.z, 1); SC_E(5, w0b.y, w1b.y, w2b.y, gb.z, gc0.z, h0.z, gc1.z, h1.z, gc2.z, h2.z, 0);
        SC_E(6, w0b.z, w1b.z, w2b.z, gb.w, gc0.w, h0.w, gc1.w, h1.w, gc2.w, h2.w, 1); SC_E(7, w0b.w, w1b.w, w2b.w, gb.w, gc0.w, h0.w, gc1.w, h1.w, gc2.w, h2.w, 0);
#undef SC_E
        *(v4u*)(MO + (size_t)row * DM + 512 + 8 * cg) = (v4u){cvtpk(o[0], o[1]), cvtpk(o[2], o[3]), cvtpk(o[4], o[5]), cvtpk(o[6], o[7])};
    }
}
__device__ __forceinline__ void phase_mixb(Frame& F, int layer) {
    const int gw = F.vcu * NWAVES + F.wave, NGW = F.G * NWAVES; const int nrows = layer == 0 ? MT : MX;
    bf16* MO = (bf16*)(F.ws + WS_XM); const bf16* OB = (const bf16*)(F.ws + WS_OB); const bf16* PX = (const bf16*)(F.ws + WS_PX);
    const float* ng = IN_HG_NORM_G + layer * 128 + ((8 * F.lane) & 127);
    const f32x4 n0 = *(const f32x4*)ng, n1 = *(const f32x4*)(ng + 4);
    for (int row = gw; row < nrows; row += NGW) {
        const v4u a = *(const v4u*)(MO + (size_t)row * DM + 8 * F.lane), bq = *(const v4u*)(OB + (size_t)row * 512 + 8 * F.lane), gt = *(const v4u*)(PX + (size_t)row * PXW + PXC_G + 8 * F.lane);
        float o[8]; o[0] = bflo(a.x) + bflo(bq.x); o[1] = bfhi(a.x) + bfhi(bq.x); o[2] = bflo(a.y) + bflo(bq.y); o[3] = bfhi(a.y) + bfhi(bq.y);
        o[4] = bflo(a.z) + bflo(bq.z); o[5] = bfhi(a.z) + bfhi(bq.z); o[6] = bflo(a.w) + bflo(bq.w); o[7] = bfhi(a.w) + bfhi(bq.w);
        float ss = 0.f;
#pragma unroll
        for (int i = 0; i < 8; ++i) ss += o[i] * o[i];
        ss += __shfl_xor(ss, 1); ss += __shfl_xor(ss, 2); ss += __shfl_xor(ss, 4); ss += __shfl_xor(ss, 8);
        const float rs = 1.f / sqrtf(ss * (1.f / 128.f) + LN_EPS);
        const float g0 = bflo(gt.x), g1 = bfhi(gt.x), g2 = bflo(gt.y), g3 = bfhi(gt.y), g4 = bflo(gt.z), g5 = bfhi(gt.z), g6 = bflo(gt.w), g7 = bfhi(gt.w);
        *(v4u*)(MO + (size_t)row * DM + 8 * F.lane) = (v4u){cvtpk(o[0] * rs * n0.x * g0, o[1] * rs * n0.y * g1), cvtpk(o[2] * rs * n0.z * g2, o[3] * rs * n0.w * g3),
                                                            cvtpk(o[4] * rs * n1.x * g4, o[5] * rs * n1.y * g5), cvtpk(o[6] * rs * n1.z * g6, o[7] * rs * n1.w * g7)};
    }
}
constexpr size_t WS_ZERO = WS_CTL + 256 * 1024;
struct ConvCol { v4u r0, r1, r2; };
__device__ __forceinline__ void conv_tap(float (&acc)[8], const v4u av, const f32x4 w0, const f32x4 w1) {
    acc[0] += bflo(av.x) * w0.x; acc[1] += bfhi(av.x) * w0.y; acc[2] += bflo(av.y) * w0.z; acc[3] += bfhi(av.y) * w0.w;
    acc[4] += bflo(av.z) * w1.x; acc[5] += bfhi(av.z) * w1.y; acc[6] += bflo(av.w) * w1.z; acc[7] += bfhi(av.w) * w1.w;
}
__device__ __forceinline__ void phase_conv(Frame& F, int layer, int nT, int nXimg) {
    const int nXrows = nXimg * SEQ, nCrows = nT * 256 - nXrows;
    const int nItems = (nXrows + nCrows) / 16;
    const int cg = F.tid; if (cg >= DFF / 8) return;
    const char* A = (const char*)(F.ws + WS_PX); char* Gb = (char*)(F.ws + WS_PX + (size_t)nT * 256 * DFF * 2);
    const char* Z = (const char*)(F.ws + WS_ZERO); const unsigned lo = 16u * (unsigned)cg;
    const float* cw = IN_FFN_CONV_W + (size_t)layer * 9 * DFF + 8 * cg; const float* cb = IN_FFN_CONV_B + (size_t)layer * DFF + 8 * cg;
    f32x4 w[9][2], bias[2];
#pragma unroll
    for (int t = 0; t < 9; ++t) { w[t][0] = *(const f32x4*)(cw + t * DFF); w[t][1] = *(const f32x4*)(cw + t * DFF + 4); }
    bias[0] = *(const f32x4*)cb; bias[1] = *(const f32x4*)(cb + 4);
    constexpr long RP = (long)DFF * 2;
    for (int it = F.vcu; it < nItems; it += F.G) {
        const int r0 = it * 16;
        int Hh, Ww, gi, gj0, imgbase;
        if (r0 < nXrows) { Hh = 32; Ww = 64; imgbase = r0 & ~(SEQ - 1); gi = (r0 - imgbase) >> 6; gj0 = (r0 - imgbase) & 63; }
        else { Hh = 1; Ww = 256; imgbase = nXrows + ((r0 - nXrows) & ~(CTXL - 1)); gi = 0; gj0 = (r0 - imgbase); }
        const bool up = gi > 0, dn = gi + 1 < Hh;
        const char* p0 = up ? A + (long)(imgbase + (gi - 1) * Ww + gj0) * RP : Z; const long s0 = up ? RP : 0;
        const char* p1 = A + (long)(imgbase + gi * Ww + gj0) * RP;
        const char* p2 = dn ? A + (long)(imgbase + (gi + 1) * Ww + gj0) * RP : Z; const long s2 = dn ? RP : 0;
        char* gp = Gb + (long)(imgbase + gi * Ww + gj0) * RP;
        const bool lft = gj0 > 0, rgt = gj0 + 16 < Ww;
#define CV_LOAD(dst, c) do { (dst).r0 = *(const v4u*)(p0 + (long)(c) * s0 + lo); (dst).r1 = *(const v4u*)(p1 + (long)(c) * RP + lo); (dst).r2 = *(const v4u*)(p2 + (long)(c) * s2 + lo); } while (0)
#define CV_OUT(j, L, M, R, gv) do { float acc[8] = {bias[0].x, bias[0].y, bias[0].z, bias[0].w, bias[1].x, bias[1].y, bias[1].z, bias[1].w}; \
        conv_tap(acc, (L).r0, w[0][0], w[0][1]); conv_tap(acc, (M).r0, w[1][0], w[1][1]); conv_tap(acc, (R).r0, w[2][0], w[2][1]); \
        conv_tap(acc, (L).r1, w[3][0], w[3][1]); conv_tap(acc, (M).r1, w[4][0], w[4][1]); conv_tap(acc, (R).r1, w[5][0], w[5][1]); \
        conv_tap(acc, (L).r2, w[6][0], w[6][1]); conv_tap(acc, (M).r2, w[7][0], w[7][1]); conv_tap(acc, (R).r2, w[8][0], w[8][1]); \
        const f32x2 e0 = pg8::gelu_pk((f32x2){acc[0], acc[1]}), e1 = pg8::gelu_pk((f32x2){acc[2], acc[3]}), e2 = pg8::gelu_pk((f32x2){acc[4], acc[5]}), e3 = pg8::gelu_pk((f32x2){acc[6], acc[7]}); \
        *(v4u*)(gp + (long)(j) * RP + lo) = (v4u){cvtpk(e0.x * bflo((gv).x), e0.y * bfhi((gv).x)), cvtpk(e1.x * bflo((gv).y), e1.y * bfhi((gv).y)), cvtpk(e2.x * bflo((gv).z), e2.y * bfhi((gv).z)), cvtpk(e3.x * bflo((gv).w), e3.y * bfhi((gv).w))}; } while (0)
        ConvCol c0, c1, c2, c3, c4, c5; v4u g0, g1, g2, g3;
        if (lft) CV_LOAD(c0, -1); else { c0.r0 = c0.r1 = c0.r2 = (v4u){0u, 0u, 0u, 0u}; }
        CV_LOAD(c1, 0); CV_LOAD(c2, 1); CV_LOAD(c3, 2);
#pragma unroll
        for (int j = 0; j < 16; j += 4) {
            asm volatile("" ::: "memory");
            CV_LOAD(c4, j + 3); if (j + 4 < 16 || rgt) CV_LOAD(c5, j + 4); else { c5.r0 = c5.r1 = c5.r2 = (v4u){0u, 0u, 0u, 0u}; }
            g0 = *(const v4u*)(gp + (long)(j) * RP + lo); g1 = *(const v4u*)(gp + (long)(j + 1) * RP + lo);
            CV_OUT(j, c0, c1, c2, g0); CV_OUT(j + 1, c1, c2, c3, g1);
            asm volatile("" ::: "memory");
            if (j + 4 < 16) { CV_LOAD(c0, j + 5); if (j + 6 < 16 || rgt) CV_LOAD(c1, j + 6); else { c1.r0 = c1.r1 = c1.r2 = (v4u){0u, 0u, 0u, 0u}; }
            }
            g2 = *(const v4u*)(gp + (long)(j + 2) * RP + lo); g3 = *(const v4u*)(gp + (long)(j + 3) * RP + lo);
            CV_OUT(j + 2, c2, c3, c4, g2); CV_OUT(j + 3, c3, c4, c5, g3);
            { const ConvCol t0 = c4, t1 = c5, t2 = c0, t3 = c1; c0 = t0; c1 = t1; c2 = t2; c3 = t3; }
        }
#undef CV_LOAD
#undef CV_OUT
    }
}
struct Args { const float* in[23]; float* out; unsigned char* ws; int ph_lo, ph_hi; };
#ifndef REP_G1
#define REP_G1 1
#endif
#ifndef REP_MIXA
#define REP_MIXA 1
#endif
#ifndef REP_G2
#define REP_G2 1
#endif
#ifndef REP_G3
#define REP_G3 1
#endif
#ifndef REP_G4
#define REP_G4 1
#endif
#ifndef PH_LIMIT
#define PH_LIMIT 1000
#endif
__global__ void __launch_bounds__(NWAVES * 64, 2) fwd_megakernel(Args args) {
    extern __shared__ __attribute__((aligned(16))) unsigned char lds[];
    Frame F;
    F.lds = (LAS unsigned char*)lds;
    F.MISC = (volatile LAS unsigned*)(F.lds + MISC_OFF);
    F.tid = threadIdx.x; F.lane = F.tid & 63; F.wave = __builtin_amdgcn_readfirstlane(F.tid >> 6);
    F.G = gridDim.x; { const int bx = blockIdx.x; F.vcu = (F.G % 8 == 0) ? (bx % 8) * (F.G / 8) + bx / 8 : bx; }
    F.ws = args.ws; F.ctl = (gu32*)(args.ws + WS_CTL); F.out = args.out;
    for (int u = F.tid; u < (LDS_BYTES - LDSCTL_OFF) / 4; u += NWAVES * 64) ((LAS unsigned*)(F.lds + LDSCTL_OFF))[u] = 0u;
    __syncthreads();
    (void)xcd_barrier_post((unsigned*)(F.ctl + CW_BAR), F.MISC + 8);
    int phase = 0;
#define PHASE_BEGIN() do { unsigned ones_ = ~0u; asm volatile("" : "+s"(ones_)); int t_ = F.wave * 64 + (int)__builtin_amdgcn_mbcnt_hi(ones_, __builtin_amdgcn_mbcnt_lo(ones_, 0u)); asm volatile("" : "+v"(t_)); F.tid = t_; F.lane = t_ & 63; unsigned long long w_ = (unsigned long long)args.ws; asm volatile("" : "+s"(w_)); F.ws = (unsigned char*)w_; \
        unsigned long long o_ = (unsigned long long)args.out; asm volatile("" : "+s"(o_)); F.out = (float*)o_; } while (0)
#ifndef DUMP_PITCH
#define DUMP_PITCH 1
#define DUMP_C0 0
#define DUMP_C1 1
#endif
#ifndef DUMP_LO
#define DUMP_LO 0
#define DUMP_HI 0
#endif
#define GRID_BAR() do { { unsigned long long wb_ = (unsigned long long)args.ws; asm volatile("" : "+s"(wb_)); XcdBarrier b_; b_.bar = (unsigned*)((gu32*)(wb_ + WS_CTL) + CW_BAR); b_.x = xb_xcc_id(); b_.st = (volatile LAS unsigned*)(F.lds + MISC_OFF) + 8; xcd_barrier(b_, F.tid); } ++phase; if (phase >= PH_LIMIT) { if (DUMP_HI > DUMP_LO) { const unsigned* src_ = (const unsigned*)(args.ws + (size_t)DUMP_LO * MiB); const size_t nw_ = (size_t)(DUMP_HI - DUMP_LO) * MiB / 4; \
        for (size_t i_ = (size_t)blockIdx.x * 512 + threadIdx.x; i_ < (size_t)MX * DM; i_ += (size_t)gridDim.x * 512) { unsigned a_ = 0u; for (size_t j_ = i_; j_ < nw_; j_ += (size_t)MX * DM) { const unsigned c_ = (unsigned)(j_ % DUMP_PITCH); if (c_ >= DUMP_C0 && c_ < DUMP_C1) a_ ^= src_[j_]; } args.out[i_] = (float)(a_ & 0xffffffu); } } return; } PHASE_BEGIN(); } while (0)
#define XM ((bf16*)(F.ws + WS_XM))
#define PXb ((bf16*)(F.ws + WS_PX))

#ifndef NO_P0
    convert_weights(F, 0, 3);
    WGBAR();
    p0_mod(F);
#endif
    GRID_BAR();
#ifndef NO_R
    phase_r1(F);
#endif
    GRID_BAR();
#pragma unroll 1
    for (int layer = 0; layer < 2; ++layer) {
for (int rep_ = 0; rep_ < REP_G1; ++rep_) {
#ifndef NO_G1
        { pg8::Gemm g{XM, (const bf16*)(F.ws + WS_WIN), MT, INC, DM}; pg8::OrderG1 S; S.init(F.G, (int)blockIdx.x, layer == 0 ? 15 : 6);
          pg8::EpiIn E{PXb, (float*)(F.ws + WS_LF), (const float*)(F.ws + WS_LBV) + layer * 1024};
          pg8::gemm_phase<pg8::EpiIn, pg8::OrderG1, true, true>(F.lds + RING_OFF, g, S, E, F.tid); }
#endif
        GRID_BAR();
}

for (int rep_ = 0; rep_ < REP_MIXA; ++rep_) {
#ifndef NO_HG
        if (F.vcu < 64) hgrn_scan(F, layer, F.vcu);
#endif
#ifndef NO_SG
        if (F.vcu >= 64) { sg_block(F, layer, F.vcu - 64); sc_items(F, layer, (F.vcu - 64) * 512 + F.tid, (F.G - 64) * 512); }
#endif
        GRID_BAR();
}

#ifndef NO_R
        phase_mixb(F, layer);
#endif
        GRID_BAR();
for (int rep_ = 0; rep_ < REP_G2; ++rep_) {
#ifndef NO_G2
        { const int M2 = layer == 0 ? MT : MX; pg8::Gemm g{XM, (const bf16*)(F.ws + WS_WOUT), M2, DM, DM}; pg8::StaticOrder S; S.init(M2, DM, F.G, (int)blockIdx.x);
          pg8::EpiF32 E{(float*)(F.ws + WS_LF), DM, nullptr};
          pg8::gemm_phase<pg8::EpiF32, pg8::StaticOrder, true, true>(F.lds + RING_OFF, g, S, E, F.tid); }
#endif
        GRID_BAR();
}

#ifndef NO_R
        phase_r2(F, layer);
        WGBAR();
#endif
#ifndef NO_P0
        if (layer == 0) convert_weights(F, 1, 1); else convert_weights(F, 1, 2);
#endif
        GRID_BAR();
        const int njobs = layer == 0 ? 2 : 1;
#pragma unroll 1
        for (int job = 0; job < njobs; ++job) {
            int nT, split, off1, off2, nXimg;
            if (layer == 0) { if (job == 0) { nT = 40; split = 32; off1 = 0; off2 = 32; nXimg = 4; } else { nT = 32; split = 32; off1 = 32; off2 = 32; nXimg = 4; } }
            else { nT = 64; split = 64; off1 = 0; off2 = 0; nXimg = 8; }
for (int rep_ = 0; rep_ < REP_G3; ++rep_) {
#ifndef NO_G3
            { pg8::Gemm g{XM, (const bf16*)(F.ws + WS_WUP), nT * 256, 2 * DFF, DM}; pg8::OrderJob S; S.init(nT, 22, F.G, (int)blockIdx.x, split, off1, off2);
              pg8::EpiBf16<0> E{PXb, DFF, nullptr, DFF, (size_t)nT * 256 * DFF, 1.f};
              pg8::gemm_phase<pg8::EpiBf16<0>, pg8::OrderJob, true, true>(F.lds + RING_OFF, g, S, E, F.tid); }
#endif
            GRID_BAR();
}

#ifndef NO_CONV
            phase_conv(F, layer, nT, nXimg);
#endif
            GRID_BAR();
for (int rep_ = 0; rep_ < REP_G4; ++rep_) {
#ifndef NO_G4
            { pg8::Gemm g{PXb + (size_t)nT * 256 * DFF, (const bf16*)(F.ws + WS_WDN), nT * 256, DM, DFF}; pg8::StaticOrder S; S.init(nT * 256, DM, F.G, (int)blockIdx.x);
              pg8::EpiF32 E{(float*)(F.ws + WS_PX), DM, nullptr};
              pg8::gemm_phase<pg8::EpiF32, pg8::StaticOrder, true, true>(F.lds + RING_OFF, g, S, E, F.tid); }
#endif
            GRID_BAR();
}

#ifndef NO_R
            phase_r3(F, layer, nT, split, off1, off2);
#endif
            if (!(layer == 1)) GRID_BAR();
        }
    }
}

extern "C" void kernel_launch(void* const* d_in, const int* in_sizes, int n_in, void* d_out, int out_size, void* d_ws, size_t ws_size, hipStream_t stream) {
    static int grid = 0;
    if (grid == 0) {
        if (n_in != 23 || in_sizes[0] != MX * DM || out_size != MX * DM || ws_size < WS_END) { fprintf(stderr, "kernel_launch: unexpected shapes (n_in %d, in0 %d, out %d, ws %zu); nothing launched\n", n_in, n_in > 0 ? in_sizes[0] : -1, out_size, ws_size); grid = -1; return; }
        int dev = 0, cus = 0, per_cu = 0;
        if (hipGetDevice(&dev) != hipSuccess || hipDeviceGetAttribute(&cus, hipDeviceAttributeMultiprocessorCount, dev) != hipSuccess) { grid = -1; return; }
        if (hipFuncSetAttribute((const void*)fwd_megakernel, hipFuncAttributeMaxDynamicSharedMemorySize, LDS_BYTES) != hipSuccess) { fprintf(stderr, "kernel_launch: hipFuncSetAttribute failed\n"); grid = -1; return; }
        if (hipOccupancyMaxActiveBlocksPerMultiprocessor(&per_cu, (const void*)fwd_megakernel, NWAVES * 64, LDS_BYTES) != hipSuccess || per_cu < 1) { fprintf(stderr, "kernel_launch: occupancy query says %d workgroups per CU; nothing launched\n", per_cu); (void)hipGetLastError(); grid = -1; return; }
        grid = cus;
    }
    if (grid < 0) return;
    if (hipMemsetAsync((char*)d_ws + WS_CTL, 0, CTL_ZERO_BYTES, stream) != hipSuccess) return;
    Args a{};
    for (int i = 0; i < 23; ++i) a.in[i] = (const float*)d_in[i];
    a.out = (float*)d_out; a.ws = (unsigned char*)d_ws; a.ph_lo = 0; a.ph_hi = 0;
    hipLaunchKernelGGL(fwd_megakernel, dim3(grid), dim3(NWAVES * 64), LDS_BYTES, stream, a);
}
```
